# Optimizing an MI355X kernel written in HIP

```python
import jax, jax.numpy as jnp
from jax import lax
import numpy as np

D_MODEL = 1024
BATCH = 32
SEQ = 2048
DEPTH = 2
DEC_BATCH = 8
DEC_SEQ = 16
PAST_LEN = 4096

CHUNK = 64
N_META = 16
Q_BLOCK = 128
EPS = 1e-6
MLA_HEADS = 8
QK_NOPE = 64
QK_ROPE = 32
V_HEAD = 64
Q_LORA = 256
KV_LORA = 128
ROPE_THETA = 10000.0
HG_HEADS = 4
HG_DK = 128
HG_DV = 128
D_FF = 2816
CONV_W = 3

MLA_WIDTH = MLA_HEADS * V_HEAD
HG_KW = HG_HEADS * HG_DK
HG_WIDTH = HG_HEADS * HG_DV
MIX_WIDTH = MLA_WIDTH + HG_WIDTH
IN_WIDTH = Q_LORA + KV_LORA + QK_ROPE + 2 * HG_KW + 2 * HG_WIDTH

kernel_name = 'hymba_mla_hgrn2_convglu_stream_step'


def rmsnorm(x, w):
    xf = x.astype(jnp.float32)
    y = xf * lax.rsqrt(jnp.mean(xf * xf, axis=-1, keepdims=True) + EPS)
    return (y * w.astype(jnp.float32)).astype(x.dtype)


def rope(x, pos):
    half = QK_ROPE // 2
    inv = ROPE_THETA ** (-jnp.arange(half, dtype=jnp.float32) / half)
    ang = pos.astype(jnp.float32)[:, None] * inv
    ang = ang.reshape((ang.shape[0],) + (1,) * (x.ndim - 3) + (half,))
    cos, sin = jnp.cos(ang), jnp.sin(ang)
    xf = x.astype(jnp.float32)
    x1, x2 = xf[..., :half], xf[..., half:]
    return jnp.concatenate([x1 * cos - x2 * sin, x1 * sin + x2 * cos], axis=-1).astype(x.dtype)


def split_in(z):
    sizes = (Q_LORA, KV_LORA, QK_ROPE, HG_KW, HG_KW, HG_WIDTH, HG_WIDTH)
    outs, off = [], 0
    for s in sizes:
        outs.append(z[..., off:off + s])
        off += s
    return outs


def mla_core(q_lat, q_pe, kv_lat, k_pe, q_pos, k_pos):
    scale = (QK_NOPE + QK_ROPE) ** -0.5
    s = (jnp.einsum('bthr,bsr->bhts', q_lat, kv_lat)
         + jnp.einsum('bthp,bsp->bhts', q_pe, k_pe)).astype(jnp.float32) * scale
    allowed = (q_pos // CHUNK)[:, None] >= (k_pos // CHUNK)[None, :]
    s = jnp.where(allowed[None, None], s, -jnp.inf)
    p = jax.nn.softmax(s, axis=-1).astype(kv_lat.dtype)
    return jnp.einsum('bhts,bsr->bthr', p, kv_lat)


def mla_prompt(q_lat, q_pe, kv_lat, k_pe, pos):
    L = q_lat.shape[1]
    outs = []
    for start in range(0, L, Q_BLOCK):
        stop = min(start + Q_BLOCK, L)
        last_chunk = (stop - 1 - N_META) // CHUNK
        kmax = min(L, N_META + (last_chunk + 1) * CHUNK)
        outs.append(mla_core(q_lat[:, start:stop], q_pe[:, start:stop], kv_lat[:, :kmax],
                             k_pe[:, :kmax], pos[start:stop], pos[:kmax]))
    return jnp.concatenate(outs, axis=1)


def hgrn_chunk(S, q, gl, k, v):
    C = q.shape[1]
    G = jnp.cumsum(gl, axis=1)
    G_last = G[:, -1]
    o_inter = jnp.einsum('bthk,bhkv->bthv', q * jnp.exp(G), S)
    tri = jnp.tril(jnp.ones((C, C), dtype=bool))
    diff = G[:, :, None] - G[:, None, :]
    decay = jnp.exp(jnp.where(tri[None, :, :, None, None], diff, -jnp.inf))
    A = jnp.einsum('bthk,btshk,bshk->bhts', q, decay, k)
    o = o_inter + jnp.einsum('bhts,bshv->bthv', A, v)
    S_new = jnp.exp(G_last)[..., None] * S + jnp.einsum('bshk,bshv->bhkv', k * jnp.exp(G_last[:, None] - G), v)
    return S_new, o


def hgrn2(hq, hf, hi, hg, lb, gain, S0, is_prompt):
    B, T, _ = hq.shape
    f32 = jnp.float32
    q = jax.nn.silu(hq.astype(f32)).reshape(B, T, HG_HEADS, HG_DK)
    zf = hf.astype(f32).reshape(B, T, HG_HEADS, HG_DK)
    lbh = lb.reshape(HG_HEADS, HG_DK)
    f = lbh + (1.0 - lbh) * jax.nn.sigmoid(zf)
    gl = jnp.log(f)
    k = (1.0 - lbh) * jax.nn.sigmoid(-zf)
    v = hi.astype(f32).reshape(B, T, HG_HEADS, HG_DV)
    S0 = S0.astype(f32)
    if is_prompt:
        n_pad = (-T) % CHUNK
        n_chunks = (T + n_pad) // CHUNK

        def to_chunks(a):
            a = jnp.pad(a, ((0, 0), (n_pad, 0), (0, 0), (0, 0)))
            return a.reshape(B, n_chunks, CHUNK, HG_HEADS, a.shape[-1]).swapaxes(0, 1)

        def step(S, xs):
            return hgrn_chunk(S, *xs)

        S_new, o = lax.scan(step, S0, (to_chunks(q), to_chunks(gl), to_chunks(k), to_chunks(v)))
        o = o.swapaxes(0, 1).reshape(B, n_chunks * CHUNK, HG_HEADS, HG_DV)[:, n_pad:]
    else:
        S_new, o = hgrn_chunk(S0, q, gl, k, v)
    o = rmsnorm(o, gain) * jax.nn.silu(hg.astype(f32).reshape(B, T, HG_HEADS, HG_DV))
    return o.reshape(B, T, HG_WIDTH).astype(hq.dtype), S_new


def token_mixers(h, pos, p, lb, kv_past, pe_past, past_pos, S0, is_prompt):
    B, T, _ = h.shape
    c_q, c_kv, k_pe, hq, hf, hi, hg = split_in(h @ p['w_in'])
    q = (rmsnorm(c_q, p['q_norm']) @ p['w_uq']).reshape(B, T, MLA_HEADS, QK_NOPE + QK_ROPE)
    q_nope = q[..., :QK_NOPE]
    q_pe = rope(q[..., QK_NOPE:], pos)
    kv_lat = rmsnorm(c_kv, p['kv_norm'])
    k_pe = rope(k_pe, pos)
    q_lat = jnp.einsum('bthd,rhd->bthr', q_nope, p['w_uk'])
    if is_prompt:
        o_lat = mla_prompt(q_lat, q_pe, kv_lat, k_pe, pos)
    else:
        o_lat = mla_core(q_lat, q_pe,
                         jnp.concatenate([kv_past.astype(kv_lat.dtype), kv_lat], axis=1),
                         jnp.concatenate([pe_past.astype(k_pe.dtype), k_pe], axis=1),
                         pos, jnp.concatenate([past_pos, pos]))
    o_a = jnp.einsum('bthr,rhd->bthd', o_lat, p['w_uv']).reshape(B, T, MLA_WIDTH)
    o_b, S_new = hgrn2(hq, hf, hi, hg, lb, p['hg_out_norm'], S0, is_prompt)
    y = jnp.concatenate([o_a, o_b], axis=-1) @ p['w_out']
    return y, kv_lat, k_pe, S_new


def conv_ffn(h, p, buf):
    u = h @ p['w_ffn_up']
    a, v = u[..., :D_FF], u[..., D_FF:]
    T = a.shape[1]
    ext = jnp.concatenate([buf.astype(a.dtype), a], axis=1)
    w = p['ffn_conv_w']
    c = p['ffn_conv_b'] + sum(ext[:, j:j + T] * w[j] for j in range(CONV_W))
    out = (jax.nn.silu(c) * v) @ p['w_ffn_down']
    return out, ext[:, -(CONV_W - 1):]


def layer(x, pos, p, lb, kv_past, pe_past, past_pos, S0, conv_buf, is_prompt):
    h = rmsnorm(x, p['norm_mix_pre'])
    mix, kv_lat, k_pe, S_new = token_mixers(h, pos, p, lb, kv_past, pe_past, past_pos, S0, is_prompt)
    x = x + rmsnorm(mix, p['norm_mix_post'])
    h = rmsnorm(x, p['norm_ffn_pre'])
    f, buf = conv_ffn(h, p, conv_buf)
    x = x + rmsnorm(f, p['norm_ffn_post'])
    return x, kv_lat, k_pe, S_new, buf


def setup_inputs(seed: int = 0) -> dict:
    key = jax.random.key(seed)
    ks = jax.random.split(key, 26)
    f32 = jnp.float32

    def nrm(k, shape, scale=1.0):
        return jax.random.normal(k, shape, f32) * scale

    def gain(k, shape):
        return 1.0 + 0.05 * jax.random.normal(k, shape, f32)

    return {
        'x_prompt': nrm(ks[0], (BATCH, SEQ, D_MODEL)),
        'x_sample': nrm(ks[1], (DEC_BATCH, DEC_SEQ, D_MODEL)),
        'cache_kv_latent': nrm(ks[2], (DEPTH, DEC_BATCH, PAST_LEN, KV_LORA)),
        'cache_k_rope': nrm(ks[3], (DEPTH, DEC_BATCH, PAST_LEN, QK_ROPE)),
        'state_hgrn': nrm(ks[4], (DEPTH, DEC_BATCH, HG_HEADS, HG_DK, HG_DV), 0.5),
        'state_ffn_conv': nrm(ks[5], (DEPTH, DEC_BATCH, CONV_W - 1, D_FF)),
        'meta_tokens': nrm(ks[6], (N_META, D_MODEL)),
        'w_in': nrm(ks[7], (DEPTH, D_MODEL, IN_WIDTH), D_MODEL ** -0.5),
        'norm_mix_pre': gain(ks[8], (DEPTH, D_MODEL)),
        'norm_mix_post': gain(ks[9], (DEPTH, D_MODEL)),
        'q_norm': gain(ks[10], (DEPTH, Q_LORA)),
        'kv_norm': gain(ks[11], (DEPTH, KV_LORA)),
        'w_uq': nrm(ks[12], (DEPTH, Q_LORA, MLA_HEADS * (QK_NOPE + QK_ROPE)), Q_LORA ** -0.5),
        'w_uk': nrm(ks[13], (DEPTH, KV_LORA, MLA_HEADS, QK_NOPE), KV_LORA ** -0.5),
        'w_uv': nrm(ks[14], (DEPTH, KV_LORA, MLA_HEADS, V_HEAD), KV_LORA ** -0.5),
        'hg_lower_bounds': 1.0 + 0.1 * jax.random.normal(ks[15], (DEPTH, HG_KW), f32),
        'hg_out_norm': gain(ks[16], (DEPTH, HG_DV)),
        'w_out': nrm(ks[17], (DEPTH, MIX_WIDTH, D_MODEL), MIX_WIDTH ** -0.5),
        'norm_ffn_pre': gain(ks[18], (DEPTH, D_MODEL)),
        'norm_ffn_post': gain(ks[19], (DEPTH, D_MODEL)),
        'w_ffn_up': nrm(ks[20], (DEPTH, D_MODEL, 2 * D_FF), D_MODEL ** -0.5),
        'ffn_conv_w': nrm(ks[21], (DEPTH, CONV_W, D_FF), CONV_W ** -0.5),
        'ffn_conv_b': nrm(ks[22], (DEPTH, D_FF), 0.01),
        'w_ffn_down': nrm(ks[23], (DEPTH, D_FF, D_MODEL), D_FF ** -0.5),
        'final_norm': gain(ks[24], (D_MODEL,)),
    }


def reference(x_prompt, x_sample, cache_kv_latent, cache_k_rope, state_hgrn, state_ffn_conv,
              meta_tokens, w_in, norm_mix_pre, norm_mix_post, q_norm, kv_norm, w_uq, w_uk, w_uv,
              hg_lower_bounds, hg_out_norm, w_out, norm_ffn_pre, norm_ffn_post, w_ffn_up,
              ffn_conv_w, ffn_conv_b, w_ffn_down, final_norm):
    lb_sm = jax.nn.softmax(hg_lower_bounds.astype(jnp.float32), axis=0)
    lb_all = jnp.cumsum(lb_sm, axis=0) - lb_sm[0]

    B = x_prompt.shape[0]
    Bs, Ts = x_sample.shape[0], x_sample.shape[1]
    meta = jnp.broadcast_to(meta_tokens.astype(x_prompt.dtype)[None], (B, N_META, D_MODEL))
    xp = jnp.concatenate([meta, x_prompt], axis=1)
    pos_p = jnp.arange(xp.shape[1], dtype=jnp.int32) - N_META
    past_pos = jnp.arange(cache_kv_latent.shape[2], dtype=jnp.int32)
    pos_s = cache_kv_latent.shape[2] + jnp.arange(Ts, dtype=jnp.int32)
    xs = x_sample

    p_kv, p_pe, p_S, p_buf = [], [], [], []
    s_kv, s_pe, s_S, s_buf = [], [], [], []
    for l in range(DEPTH):
        p = {'w_in': w_in[l], 'norm_mix_pre': norm_mix_pre[l], 'norm_mix_post': norm_mix_post[l],
             'q_norm': q_norm[l], 'kv_norm': kv_norm[l], 'w_uq': w_uq[l], 'w_uk': w_uk[l],
             'w_uv': w_uv[l], 'hg_out_norm': hg_out_norm[l], 'w_out': w_out[l],
             'norm_ffn_pre': norm_ffn_pre[l], 'norm_ffn_post': norm_ffn_post[l],
             'w_ffn_up': w_ffn_up[l], 'ffn_conv_w': ffn_conv_w[l], 'ffn_conv_b': ffn_conv_b[l],
             'w_ffn_down': w_ffn_down[l]}
        S0_p = jnp.zeros((B, HG_HEADS, HG_DK, HG_DV), jnp.float32)
        buf0_p = jnp.zeros((B, CONV_W - 1, D_FF), xp.dtype)
        xp, kv, pe, S, buf = layer(xp, pos_p, p, lb_all[l], None, None, None, S0_p, buf0_p, True)
        p_kv.append(kv); p_pe.append(pe); p_S.append(S); p_buf.append(buf)
        xs, kv, pe, S, buf = layer(xs, pos_s, p, lb_all[l], cache_kv_latent[l], cache_k_rope[l],
                                   past_pos, state_hgrn[l], state_ffn_conv[l], False)
        s_kv.append(kv); s_pe.append(pe); s_S.append(S); s_buf.append(buf)

    y_prompt = rmsnorm(xp[:, N_META:], final_norm)
    y_sample = rmsnorm(xs, final_norm)
    return (y_prompt, y_sample,
            jnp.stack(p_kv), jnp.stack(p_pe), jnp.stack(p_S), jnp.stack(p_buf),
            jnp.stack(s_kv), jnp.stack(s_pe), jnp.stack(s_S), jnp.stack(s_buf))
```

```cpp
#include <hip/hip_runtime.h>
#include <hip/hip_cooperative_groups.h>
#include <cstdio>
namespace cg = cooperative_groups;

#ifndef PHMASK
#define PHMASK 0x1ff
#endif
#ifndef REPMASK
#define REPMASK 0
#endif
#ifndef MULTI
#define MULTI 0
#endif

#define LAS __attribute__((address_space(3)))
#define DI __device__ __forceinline__
typedef unsigned short bf16_t;
typedef short bf16x8 __attribute__((ext_vector_type(8)));
typedef short s16x4 __attribute__((ext_vector_type(4)));
typedef float f32x4 __attribute__((ext_vector_type(4)));
typedef float f32x2 __attribute__((ext_vector_type(2)));
typedef float f32x16 __attribute__((ext_vector_type(16)));
typedef unsigned u32x4 __attribute__((ext_vector_type(4)));
typedef unsigned u32x2 __attribute__((ext_vector_type(2)));

constexpr int DM = 1024, NB = 32, TT = 2064, NMETA = 16, SB = 8, ST_ = 16, PAST = 4096;
constexpr int NTP = NB * TT;
constexpr int NTOK = NTP + SB * ST_;
constexpr int MP = 66304;
constexpr int ZW = 2560, DFF = 2816, INW = 2464;
constexpr int ZC_KV = 256, ZC_HQ = 384, ZC_HF = 896, ZC_HI = 1408, ZC_HG = 1920, ZC_PE = 2432;
constexpr int SKV = PAST + ST_;
constexpr int SKVP = 4160;
constexpr int VTLD_P = 2112;
constexpr float EPS = 1e-6f;
constexpr int ZROW = MP - 1;
constexpr int NSUBP = (NTP + 125) / 126;
constexpr int NMUP = (NSUBP + 1 + 1) / 2;

constexpr long O_YP = 0, O_YS = 67108864L, O_PKV = 67239936L, O_PPE = 84148224L, O_PS = 88375296L, O_PCONV = 92569600L,
               O_SKV = 92930048L, O_SPE = 92962816L, O_SS = 92971008L, O_SCONV = 94019584L;

constexpr size_t al256(size_t x) { return (x + 255) & ~(size_t)255; }
constexpr size_t WS_X = 0;
constexpr size_t WS_H = WS_X + al256((size_t)MP * 1024 * 4);
constexpr size_t WS_Z = WS_H + al256((size_t)MP * 1024 * 2);
constexpr size_t WS_QL = WS_Z + al256((size_t)MP * ZW * 2);
constexpr size_t WS_QP = WS_QL + al256((size_t)MP * 1024 * 2);
constexpr size_t WS_G = WS_Z;
constexpr size_t WS_KBP = WS_QP + al256((size_t)MP * 256 * 2);
constexpr size_t WS_KBS = WS_KBP + al256((size_t)(NTP + 64) * 160 * 2);
constexpr size_t WS_VTP = WS_KBS + al256((size_t)SB * SKVP * 160 * 2);
constexpr size_t WS_VTS = WS_VTP + al256((size_t)NB * 128 * VTLD_P * 2);
constexpr size_t WS_WIN = WS_VTS + al256((size_t)SB * 128 * SKVP * 2);
constexpr size_t WS_WQ = WS_WIN + al256((size_t)2 * ZW * 1024 * 2);
constexpr size_t WS_WO = WS_WQ + al256((size_t)2 * 1280 * 256 * 2);
constexpr size_t WS_WUP = WS_WO + al256((size_t)2 * 1024 * 1536 * 2);
constexpr size_t WS_WD = WS_WUP + al256((size_t)2 * 5632 * 1024 * 2);
constexpr size_t WS_RS = WS_WD + al256((size_t)2 * 1024 * DFF * 2);
constexpr size_t WS_ROPE = WS_RS + al256((size_t)MP * 16 * 4);
constexpr size_t WS_LB = WS_ROPE + al256((size_t)2080 * 16 * 2 * 4);
constexpr size_t WS_CNT = WS_LB + al256(512 * 4);
constexpr size_t WS_END = WS_CNT + 8192;
static_assert((size_t)MP * DFF * 2 <= (WS_QP - WS_Z), "G overlay");

struct Params {
    const float *x_prompt, *x_sample, *cache_kv, *cache_pe, *state_hgrn, *state_conv, *meta, *w_in, *n_mix_pre, *n_mix_post,
        *q_norm, *kv_norm, *w_uq, *w_uk, *w_uv, *hg_lb, *hg_on, *w_out, *n_ffn_pre, *n_ffn_post, *w_up, *conv_w, *conv_b, *w_down, *final_norm;
    float* out;
    char* ws;
    int ph_lo, ph_hi;
};

DI unsigned pk2(float lo, float hi) {
    typedef __bf16 bf2 __attribute__((ext_vector_type(2)));
    f32x2 v = {lo, hi};
    bf2 r = __builtin_convertvector(v, bf2);
    return __builtin_bit_cast(unsigned, r);
}
DI bf16_t f2bf(float x) { return (bf16_t)(pk2(x, 0.f) & 0xffffu); }
DI float bf2f(bf16_t u) { return __uint_as_float(((unsigned)u) << 16); }
DI float bflo(unsigned u) { return __uint_as_float(u << 16); }
DI float bfhi(unsigned u) { return __uint_as_float(u & 0xffff0000u); }
DI float sigmoidf_(float x) { return 1.0f / (1.0f + __expf(-x)); }
DI float siluf_(float x) { return x / (1.0f + __expf(-x)); }
DI float wave_sum(float v) {
#pragma unroll
    for (int o = 32; o >= 1; o >>= 1) v += __shfl_xor(v, o);
    return v;
}
DI int pos_index(long g) {
    if (g < NTP) return (int)(g % TT);
    long r = g - NTP; if (r >= SB * ST_) r = 0;
    return TT + (int)(r % ST_);
}

constexpr int BK = 64, TILE_B = 256 * BK * 2, STAGE_B = 2 * TILE_B;
DI int lds_byte(int r, int c) {
    int st = (r >> 4) * 2 + (c >> 5), ob = (r & 15) * 64 + (c & 31) * 2;
    return st * 1024 + (ob ^ (((ob >> 9) & 1) << 5));
}
DI void stage_rc(int b, int& R, int& C) {
    int st = b >> 10, sb = b & 1023, swz = sb ^ (((sb >> 9) & 1) << 5);
    R = (st / 2) * 16 + swz / 64;
    C = (st % 2) * 32 + (swz % 64) / 2;
}
#define WAIT_V0() asm volatile("s_waitcnt vmcnt(0)" ::: "memory")

struct GemmA { const bf16_t* p0; long ld0; const bf16_t* p1; long ld1; int K0; };

DI void tile_decode(int v, int nM, int nN, int& pm, int& pn) {
    const int nig = 8 * nN, gid = v / nig, fm = gid * 8, rem = v - gid * nig;
    const int gsz = (nM - fm) < 8 ? (nM - fm) : 8;
    pn = rem / gsz; pm = fm + rem - pn * gsz;
}
template <bool TWO, class RowMap, class Epi>
DI void gemm_phase(int tid0, int bid, const unsigned* cnt, LAS char* shA, LAS char* shB, const GemmA ga, const RowMap& rowmap, const bf16_t* W, int K, int nM, int nN, const Epi& epi) {
    int tid = tid0; asm volatile("" : "+v"(tid));
    const int wid = __builtin_amdgcn_readfirstlane(tid >> 6), wr = wid >> 2, wc = wid & 3;
    const int G = gridDim.x, ntiles = nM * nN;
    int vb;
    {
        const unsigned info = cnt[64 + bid], xcc = info >> 16;
        unsigned pre = 0;
#pragma unroll
        for (unsigned x = 0; x < 8; ++x) { const unsigned c = cnt[16 + x]; pre += x < xcc ? c : 0u; }
        vb = (int)(pre + (info & 0xffffu));
    }
    int v = vb;
    if (v >= ntiles) return;
    int pm, pn; tile_decode(v, nM, nN, pm, pn);
    unsigned offA0[4], offA1[4], offB[4];
#define G_OFFS(PM, PN) do { int lo_ = tid; asm volatile("" : "+v"(lo_)); lo_ &= 63; _Pragma("unroll") for (int i = 0; i < 4; ++i) { int R, C; stage_rc(wid * 1024 + i * 8192 + lo_ * 16, R, C); \
        const unsigned gr = (unsigned)rowmap((PM), R); offA0[i] = gr * (unsigned)ga.ld0 + C; offA1[i] = TWO ? gr * (unsigned)ga.ld1 + C - ga.K0 : 0u; \
        offB[i] = (unsigned)(((PN) * 256 + R) * K + C); } } while (0)
#define G_PIECE(buf, kt, p) do { if ((p) < 4) { \
            const bf16_t* srcA = (!TWO || (kt) * BK < ga.K0) ? (ga.p0 + (offA0[(p) & 3] + (kt) * BK)) : (ga.p1 + (offA1[(p) & 3] + (kt) * BK)); \
            __builtin_amdgcn_global_load_lds((const unsigned*)srcA, (LAS unsigned*)(((buf) ? shB : shA) + wid * 1024 + ((p) & 3) * 8192), 16, 0, 0); \
        } else { \
            __builtin_amdgcn_global_load_lds((const unsigned*)(W + (offB[(p) & 3] + (kt) * BK)), (LAS unsigned*)(((buf) ? shB : shA) + TILE_B + wid * 1024 + ((p) & 3) * 8192), 16, 0, 0); } } while (0)
#define G_STAGE(buf, kt) do { G_PIECE(buf, kt, 0); G_PIECE(buf, kt, 4); G_PIECE(buf, kt, 1); G_PIECE(buf, kt, 5); G_PIECE(buf, kt, 2); G_PIECE(buf, kt, 6); G_PIECE(buf, kt, 3); G_PIECE(buf, kt, 7); } while (0)
    G_OFFS(pm, pn);
    f32x4 acc[8][4];
#pragma unroll
    for (int m = 0; m < 8; ++m)
#pragma unroll
        for (int n = 0; n < 4; ++n) acc[m][n] = (f32x4){0.f, 0.f, 0.f, 0.f};
    const int nt = K / BK;
    __syncthreads();
    G_STAGE(0, 0); WAIT_V0(); __syncthreads();
    for (;;) {
        int pm2 = 0, pn2 = 0; bool more = false;
        int tl = tid; asm volatile("" : "+v"(tl));
        const int lane = tl & 63, fr = lane & 15, fq = lane >> 4;
        const int fo_ = fr * 64 + fq * 16, fo = fo_ ^ (((fo_ >> 9) & 1) << 5);
        const int aoffA = wr * 16384 + fo, aoffB = TILE_B + wc * 8192 + fo;
        const unsigned abase0 = (unsigned)(unsigned long)(shA + aoffA), abase1 = (unsigned)(unsigned long)(shB + aoffA);
        const unsigned bbase0 = (unsigned)(unsigned long)(shA + aoffB), bbase1 = (unsigned)(unsigned long)(shB + aoffB);
#define G_RD(dst, addr, off) asm volatile("ds_read_b128 %0, %1 offset:%2" : "=v"(dst) : "v"(addr), "n"(off))
#define G_MM(m, i, cb) do { _Pragma("unroll") for (int n = 0; n < 4; ++n) \
            asm volatile("v_mfma_f32_16x16x32_bf16 %0, %1, %2, %0" : "+v"(acc[(m)][n]) : "v"(Bq[n]), "v"(Aq[cb][i])); } while (0)
#define G_GROUP(ab, bb, g, WN, nbuf, st, kt) do { \
            if ((g) + 1 < 8) { G_RD(Aq[((g) & 1) ^ 1][0], ab, ((((g) + 1) >> 2) * 1024 + (2 * (((g) + 1) & 3)) * 2048)); \
                               G_RD(Aq[((g) & 1) ^ 1][1], ab, ((((g) + 1) >> 2) * 1024 + (2 * (((g) + 1) & 3) + 1) * 2048)); } \
            if ((g) < 4) { if (st) { G_PIECE(nbuf, kt, (g)); G_PIECE(nbuf, kt, (g) + 4); } } \
            asm volatile("s_waitcnt lgkmcnt(" #WN ")" ::: "memory"); \
            __builtin_amdgcn_s_setprio(1); \
            G_MM(2 * ((g) & 3), 0, (g) & 1); G_MM(2 * ((g) & 3) + 1, 1, (g) & 1); \
            __builtin_amdgcn_s_setprio(0); \
            if ((g) == 3) { asm volatile("s_nop 1"); G_RD(Bq[0], bb, 1024); G_RD(Bq[1], bb, 1024 + 2048); G_RD(Bq[2], bb, 1024 + 4096); G_RD(Bq[3], bb, 1024 + 6144); } \
            __builtin_amdgcn_sched_barrier(0); \
        } while (0)
#define G_COMPUTE(buf, st, kt) do { bf16x8 Bq[4], Aq[2][2]; const unsigned ab = (buf) ? abase1 : abase0, bb = (buf) ? bbase1 : bbase0; \
            G_RD(Bq[0], bb, 0); G_RD(Bq[1], bb, 2048); G_RD(Bq[2], bb, 4096); G_RD(Bq[3], bb, 6144); \
            G_RD(Aq[0][0], ab, 0); G_RD(Aq[0][1], ab, 2048); \
            G_GROUP(ab, bb, 0, 2, (buf) ^ 1, st, kt); G_GROUP(ab, bb, 1, 2, (buf) ^ 1, st, kt); G_GROUP(ab, bb, 2, 2, (buf) ^ 1, st, kt); G_GROUP(ab, bb, 3, 2, (buf) ^ 1, st, kt); \
            G_GROUP(ab, bb, 4, 2, (buf) ^ 1, st, kt); G_GROUP(ab, bb, 5, 2, (buf) ^ 1, st, kt); G_GROUP(ab, bb, 6, 2, (buf) ^ 1, st, kt); G_GROUP(ab, bb, 7, 0, (buf) ^ 1, st, kt); \
            } while (0)
        for (int t = 0; t < nt; t += 2) {
            G_COMPUTE(0, true, t + 1);
            WAIT_V0(); __syncthreads();
            bool st = true; int ktn = t + 2;
            if (t + 2 >= nt) {
                v += G; more = v < ntiles; st = more; ktn = 0;
                if (more) { tile_decode(v, nM, nN, pm2, pn2); G_OFFS(pm2, pn2); }
            }
            G_COMPUTE(1, st, ktn);
            WAIT_V0(); __syncthreads();
        }
#undef G_COMPUTE
#undef G_GROUP
#undef G_MM
#undef G_RD
        asm volatile("s_nop 15\n\ts_nop 7" ::: "memory");
        epi(pm, pn, acc, wr, wc, fr, fq, lane);
        if (!more) break;
        pm = pm2; pn = pn2;
#pragma unroll
        for (int m = 0; m < 8; ++m)
#pragma unroll
            for (int n = 0; n < 4; ++n) acc[m][n] = (f32x4){0.f, 0.f, 0.f, 0.f};
    }
#undef G_STAGE
#undef G_PIECE
#undef G_OFFS
}

struct EpiZ {
    bf16_t* dst; float* rs;
    DI void operator()(int pm, int pn, const f32x4 (&acc)[8][4], int wr, int wc, int fr, int fq, int) const {
#pragma unroll
        for (int m = 0; m < 8; ++m) {
            const long g = (long)pm * 256 + wr * 128 + m * 16 + fr;
            float ss = 0.f;
            if (pn == 0) {
#pragma unroll
                for (int n = 0; n < 4; ++n)
#pragma unroll
                    for (int j = 0; j < 4; ++j) ss += acc[m][n][j] * acc[m][n][j];
                ss += __shfl_xor(ss, 16); ss += __shfl_xor(ss, 32);
            }
            if (g < NTOK) {
                bf16_t* rp = dst + g * ZW + pn * 256 + wc * 64 + fq * 4;
#pragma unroll
                for (int n = 0; n < 4; ++n) { u32x2 w; w.x = pk2(acc[m][n][0], acc[m][n][1]); w.y = pk2(acc[m][n][2], acc[m][n][3]); *(u32x2*)(rp + n * 16) = w; }
                if (pn == 0 && fq == 0) rs[g * 16 + wc] = ss;
            }
            asm volatile("" ::: "memory");
        }
    }
};
struct EpiOut {
    bf16_t* dst; float* rs;
    DI void operator()(int pm, int pn, const f32x4 (&acc)[8][4], int wr, int wc, int fr, int fq, int) const {
#pragma unroll
        for (int m = 0; m < 8; ++m) {
            const long g = (long)pm * 256 + wr * 128 + m * 16 + fr;
            float ss = 0.f;
#pragma unroll
            for (int n = 0; n < 4; ++n)
#pragma unroll
                for (int j = 0; j < 4; ++j) ss += acc[m][n][j] * acc[m][n][j];
            ss += __shfl_xor(ss, 16); ss += __shfl_xor(ss, 32);
            if (g < NTOK) {
                bf16_t* rp = dst + g * 1024 + pn * 256 + wc * 64 + fq * 4;
#pragma unroll
                for (int n = 0; n < 4; ++n) { u32x2 w; w.x = pk2(acc[m][n][0], acc[m][n][1]); w.y = pk2(acc[m][n][2], acc[m][n][3]); *(u32x2*)(rp + n * 16) = w; }
                if (fq == 0) rs[g * 16 + pn * 4 + wc] = ss;
            }
            asm volatile("" ::: "memory");
        }
    }
};
struct EpiQ {
    bf16_t* ql; bf16_t* qp; const float* rope; const float* rs;
    DI void operator()(int pm, int pn, const f32x4 (&acc)[8][4], int wr, int wc, int fr, int fq, int) const {
#pragma unroll
        for (int m = 0; m < 8; ++m) {
            const int lr = wr * 128 + m * 16 + fr;
            const long g = (long)pm * 256 + lr;
            if (g < NTOK) {
                const f32x4 pr = *(const f32x4*)(rs + g * 16);
                const float r = rsqrtf((pr[0] + pr[1] + pr[2] + pr[3]) * (1.0f / 256.0f) + EPS);
                if (pn < 4) {
                    bf16_t* rp = ql + g * 1024 + pn * 256 + wc * 64 + fq * 4;
#pragma unroll
                    for (int n = 0; n < 4; ++n) { u32x2 w; w.x = pk2(acc[m][n][0] * r, acc[m][n][1] * r); w.y = pk2(acc[m][n][2] * r, acc[m][n][3] * r); *(u32x2*)(rp + n * 16) = w; }
                } else {
                    const float* tb = rope + (size_t)pos_index(g) * 32 + fq * 8;
                    const f32x4 c0 = *(const f32x4*)tb, c1 = *(const f32x4*)(tb + 4);
                    const float cs[4] = {c0[0], c0[2], c1[0], c1[2]}, sn[4] = {c0[1], c0[3], c1[1], c1[3]};
#pragma unroll
                    for (int hh = 0; hh < 2; ++hh) {
                        float o1[4], o2[4];
#pragma unroll
                        for (int j = 0; j < 4; ++j) { const float x1 = acc[m][2 * hh][j] * r, x2 = acc[m][2 * hh + 1][j] * r; o1[j] = x1 * cs[j] - x2 * sn[j]; o2[j] = x1 * sn[j] + x2 * cs[j]; }
                        bf16_t* rp = qp + g * 256 + wc * 64 + hh * 32 + fq * 4;
                        u32x2 w; w.x = pk2(o1[0], o1[1]); w.y = pk2(o1[2], o1[3]); *(u32x2*)rp = w;
                        w.x = pk2(o2[0], o2[1]); w.y = pk2(o2[2], o2[3]); *(u32x2*)(rp + 16) = w;
                    }
                }
            }
            asm volatile("" ::: "memory");
        }
    }
};
struct EpiUp {
    bf16_t* G; const float* cw; const float* cb; const float* sconv; float* out; int l;
    DI void operator()(int pm, int pn, const f32x4 (&acc)[8][4], int wr, int wc, int fr, int fq, int lane) const {
        const int st = 2 * pm + wr;
        const bool isP = st < NSUBP, isS = st == NSUBP;
        const int chb = pn * 128 + wc * 32 + fq * 4;
#pragma unroll
        for (int n = 0; n < 2; ++n) {
            const int ch = chb + n * 16;
            const f32x4 w0 = *(const f32x4*)(cw + (size_t)(l * 3 + 0) * DFF + ch), w1 = *(const f32x4*)(cw + (size_t)(l * 3 + 1) * DFF + ch),
                        w2 = *(const f32x4*)(cw + (size_t)(l * 3 + 2) * DFF + ch), bb = *(const f32x4*)(cb + (size_t)l * DFF + ch);
#pragma unroll
            for (int m = 0; m < 8; ++m) {
                f32x4 p1, p2;
#pragma unroll
                for (int j = 0; j < 4; ++j) {
                    const float a = acc[m][n][j];
                    const float am = acc[m > 0 ? m - 1 : 0][n][j];
                    const int ai = __builtin_bit_cast(int, a), ami = __builtin_bit_cast(int, am);
                    const float s1 = __builtin_bit_cast(float, __builtin_amdgcn_update_dpp(0, ai, 0x111, 0xf, 0xf, true));
                    const float s2 = __builtin_bit_cast(float, __builtin_amdgcn_update_dpp(0, ai, 0x112, 0xf, 0xf, true));
                    const float t1 = __builtin_bit_cast(float, __builtin_amdgcn_update_dpp(0, ami, 0x121, 0xf, 0xf, true));
                    const float t2 = __builtin_bit_cast(float, __builtin_amdgcn_update_dpp(0, ami, 0x122, 0xf, 0xf, true));
                    p1[j] = fr >= 1 ? s1 : t1;
                    p2[j] = fr >= 2 ? s2 : t2;
                }
                const int lr = m * 16 + fr;
                if (isP) {
                    const int gg = 126 * st - 2 + lr;
                    if (lr >= 2 && gg < NTP) {
                        const int b = gg / TT, t = gg - b * TT;
                        const long g = gg;
                        if (t < 1) p1 = (f32x4){0.f, 0.f, 0.f, 0.f};
                        if (t < 2) p2 = (f32x4){0.f, 0.f, 0.f, 0.f};
                        f32x4 gv;
#pragma unroll
                        for (int j = 0; j < 4; ++j) { const float c = bb[j] + w0[j] * p2[j] + w1[j] * p1[j] + w2[j] * acc[m][n][j]; gv[j] = siluf_(c) * acc[m][n + 2][j]; }
                        u32x2 w; w.x = pk2(gv[0], gv[1]); w.y = pk2(gv[2], gv[3]);
                        *(u32x2*)(G + g * DFF + ch) = w;
                        if (t >= TT - 2) *(f32x4*)(out + O_PCONV + ((size_t)(l * NB + b) * 2 + (t - (TT - 2))) * DFF + ch) = acc[m][n];
                    }
                } else if (isS) {
                    const int tt = fr, bs = m;
                    const float* sp = sconv + (size_t)(l * SB + bs) * 2 * DFF + ch;
                    const f32x4 b0 = *(const f32x4*)sp, b1 = *(const f32x4*)(sp + DFF);
                    if (tt == 0) { p1 = b1; p2 = b0; } else if (tt == 1) { p2 = b1; }
                    const long g = NTP + lr;
                    f32x4 gv;
#pragma unroll
                    for (int j = 0; j < 4; ++j) { const float c = bb[j] + w0[j] * p2[j] + w1[j] * p1[j] + w2[j] * acc[m][n][j]; gv[j] = siluf_(c) * acc[m][n + 2][j]; }
                    u32x2 w; w.x = pk2(gv[0], gv[1]); w.y = pk2(gv[2], gv[3]);
                    *(u32x2*)(G + g * DFF + ch) = w;
                    if (tt >= ST_ - 2) *(f32x4*)(out + O_SCONV + ((size_t)(l * SB + bs) * 2 + (tt - (ST_ - 2))) * DFF + ch) = acc[m][n];
                }
                asm volatile("" ::: "memory");
            }
        }
    }
};

DI void prep_weights(int tid0, int bid, const Params& p) {
    const long gt = (long)bid * 512 + tid0, gs = (long)gridDim.x * 512;
    bf16_t* WinT = (bf16_t*)(p.ws + WS_WIN); bf16_t* WqT = (bf16_t*)(p.ws + WS_WQ); bf16_t* WoT = (bf16_t*)(p.ws + WS_WO);
    bf16_t* WupT = (bf16_t*)(p.ws + WS_WUP); bf16_t* WdT = (bf16_t*)(p.ws + WS_WD);
    for (long i = gt; i < 2L * 128 * ZW; i += gs) {
        const int n = (int)(i % ZW), k8 = (int)((i / ZW) % 128), l = (int)(i / (ZW * 128));
        int src = -1;
        if (n < 384) src = n; else if (n < 2432) src = n + 32; else if (n < 2464) src = n - 2432 + 384;
        float v[8];
#pragma unroll
        for (int e = 0; e < 8; ++e) v[e] = src >= 0 ? p.w_in[((size_t)l * 1024 + k8 * 8 + e) * INW + src] : 0.f;
        u32x4 w = {pk2(v[0], v[1]), pk2(v[2], v[3]), pk2(v[4], v[5]), pk2(v[6], v[7])};
        *(u32x4*)(WinT + ((size_t)l * ZW + n) * 1024 + k8 * 8) = w;
    }
    for (long i = gt; i < 2L * 128 * 5632; i += gs) {
        const int n = (int)(i % 5632), k8 = (int)((i / 5632) % 128), l = (int)(i / (5632 * 128));
        const int pn = n >> 8, c = n & 255, wc = c >> 6, nn = (c >> 4) & 3, ii = c & 15;
        const int ch = pn * 128 + wc * 32 + (nn & 1) * 16 + ii;
        const int src = nn < 2 ? ch : DFF + ch;
        float v[8];
#pragma unroll
        for (int e = 0; e < 8; ++e) v[e] = p.w_up[((size_t)l * 1024 + k8 * 8 + e) * (2 * DFF) + src];
        u32x4 w = {pk2(v[0], v[1]), pk2(v[2], v[3]), pk2(v[4], v[5]), pk2(v[6], v[7])};
        *(u32x4*)(WupT + ((size_t)l * 5632 + n) * 1024 + k8 * 8) = w;
    }
    for (long i = gt; i < 2L * 352 * 1024; i += gs) {
        const int n = (int)(i % 1024), k8 = (int)((i / 1024) % 352), l = (int)(i / (1024 * 352));
        float v[8];
#pragma unroll
        for (int e = 0; e < 8; ++e) v[e] = p.w_down[((size_t)l * DFF + k8 * 8 + e) * 1024 + n];
        u32x4 w = {pk2(v[0], v[1]), pk2(v[2], v[3]), pk2(v[4], v[5]), pk2(v[6], v[7])};
        *(u32x4*)(WdT + ((size_t)l * 1024 + n) * DFF + k8 * 8) = w;
    }
    for (long i = gt; i < 2L * 192 * 1024; i += gs) {
        const int n = (int)(i % 1024), k8 = (int)((i / 1024) % 192), l = (int)(i / (1024 * 192));
        float v[8];
        if (k8 < 128) {
            const int h = k8 >> 4, r0 = (k8 & 15) * 8;
#pragma unroll
            for (int e = 0; e < 8; ++e) v[e] = 0.f;
            for (int d = 0; d < 64; ++d) {
                const float wo = p.w_out[((size_t)l * 1024 + h * 64 + d) * 1024 + n];
#pragma unroll
                for (int e = 0; e < 8; ++e) v[e] += p.w_uv[(((size_t)l * 128 + r0 + e) * 8 + h) * 64 + d] * wo;
            }
        } else {
#pragma unroll
            for (int e = 0; e < 8; ++e) v[e] = p.w_out[((size_t)l * 1024 + 512 + (k8 - 128) * 8 + e) * 1024 + n];
        }
        u32x4 w = {pk2(v[0], v[1]), pk2(v[2], v[3]), pk2(v[4], v[5]), pk2(v[6], v[7])};
        *(u32x4*)(WoT + ((size_t)l * 1024 + n) * 1536 + k8 * 8) = w;
    }
    const float qscale = 0.10206207261596577f * 1.4426950408889634f;
    for (long i = gt; i < 2L * 32 * 1280; i += gs) {
        const int n = (int)(i % 1280), k8 = (int)((i / 1280) % 32), l = (int)(i / (1280 * 32));
        float v[8];
        if (n < 1024) {
            const int h = n >> 7, r = n & 127;
#pragma unroll
            for (int e = 0; e < 8; ++e) v[e] = 0.f;
            for (int d = 0; d < 64; ++d) {
                const float wk = p.w_uk[(((size_t)l * 128 + r) * 8 + h) * 64 + d];
#pragma unroll
                for (int e = 0; e < 8; ++e) v[e] += p.w_uq[((size_t)l * 256 + k8 * 8 + e) * 768 + h * 96 + d] * wk;
            }
        } else {
            const int h = (n - 1024) >> 5, ii = (n - 1024) & 31;
#pragma unroll
            for (int e = 0; e < 8; ++e) v[e] = p.w_uq[((size_t)l * 256 + k8 * 8 + e) * 768 + h * 96 + 64 + ii];
        }
#pragma unroll
        for (int e = 0; e < 8; ++e) v[e] *= qscale * p.q_norm[l * 256 + k8 * 8 + e];
        u32x4 w = {pk2(v[0], v[1]), pk2(v[2], v[3]), pk2(v[4], v[5]), pk2(v[6], v[7])};
        *(u32x4*)(WqT + ((size_t)l * 1280 + n) * 256 + k8 * 8) = w;
    }
    float* rope = (float*)(p.ws + WS_ROPE);
    for (long i = gt; i < 2080L * 16; i += gs) {
        const int idx = (int)(i >> 4), k = (int)(i & 15);
        const int pos = idx < TT ? idx - NMETA : PAST + idx - TT;
        const float invf = __builtin_amdgcn_exp2f(-(float)k * (13.287712379549449f / 16.0f));
        const double x = (double)pos * (double)invf * 0.15915494309189535;
        const float fr = (float)(x - __builtin_rint(x));
        rope[i * 2] = __builtin_amdgcn_cosf(fr); rope[i * 2 + 1] = __builtin_amdgcn_sinf(fr);
    }
    float* lb = (float*)(p.ws + WS_LB);
    for (long i = gt; i < 512; i += gs) {
        const float a0 = p.hg_lb[i], a1 = p.hg_lb[512 + i];
        const float mx = fmaxf(a0, a1), e0 = __expf(a0 - mx), e1 = __expf(a1 - mx);
        lb[i] = e1 / (e0 + e1);
    }
    bf16_t* H = (bf16_t*)(p.ws + WS_H);
    for (long i = gt; i < 1024; i += gs) H[(size_t)ZROW * 1024 + i] = 0;
    if (tid0 == 0) {
        unsigned* cnt = (unsigned*)(p.ws + WS_CNT);
        const unsigned xcc = ((unsigned)__builtin_amdgcn_s_getreg((3 << 11) | 20)) & 7u;
        const unsigned slot = atomicAdd(cnt + 16 + xcc, 1u);
        cnt[64 + bid] = (xcc << 16) | slot;
    }
}

DI void rows_phase(int tid0, int bid, const Params& p, int mode, const float* gA, const float* gB, bool first = false) {
    bf16_t* X = (bf16_t*)(p.ws + WS_X);
    bf16_t* H = (bf16_t*)(p.ws + WS_H); const float* RS = (const float*)(p.ws + WS_RS);
    const int lane = tid0 & 63, wv = tid0 >> 6;
    const long stride = (long)gridDim.x * 8;
    constexpr int NR = 4;
    for (long g0 = (long)bid * 8 + wv; g0 < NTOK; g0 += NR * stride) {
        f32x4 x[NR][4]; u32x2 mv[NR][4]; float rsp[NR]; bool ok[NR]; long gr[NR];
#pragma unroll
        for (int u = 0; u < NR; ++u) {
            const long g = g0 + u * stride; gr[u] = g; ok[u] = g < NTOK;
            const long gc = ok[u] ? g : g0;
            const float* src = nullptr;
            if (mode == 0 || first) {
                if (gc < NTP) { const int b = (int)(gc / TT), t = (int)(gc % TT); src = t < NMETA ? p.meta + (size_t)t * 1024 : p.x_prompt + ((size_t)b * 2048 + (t - NMETA)) * 1024; }
                else src = p.x_sample + (size_t)(gc - NTP) * 1024;
            }
            rsp[u] = 0.f;
            if (mode != 0 && lane < 16) rsp[u] = RS[gc * 16 + lane];
#pragma unroll
            for (int i = 0; i < 4; ++i) {
                if (mode == 0 || first) x[u][i] = *(const f32x4*)(src + i * 256 + lane * 4);
                else { const u32x2 xv = *(const u32x2*)(X + gc * 1024 + i * 256 + lane * 4); x[u][i] = (f32x4){bflo(xv.x), bfhi(xv.x), bflo(xv.y), bfhi(xv.y)}; }
                mv[u][i] = mode != 0 ? *(const u32x2*)(H + gc * 1024 + i * 256 + lane * 4) : (u32x2){0u, 0u};
            }
        }
#pragma unroll
        for (int u = 0; u < NR; ++u) {
            if (!ok[u]) continue;
            const long g = gr[u];
            if (mode != 0) {
                const float ss = wave_sum(rsp[u]);
                const float r1 = rsqrtf(ss * (1.0f / 1024.0f) + EPS);
#pragma unroll
                for (int i = 0; i < 4; ++i) {
                    const f32x4 ga = *(const f32x4*)(gA + i * 256 + lane * 4);
                    x[u][i][0] += bflo(mv[u][i].x) * r1 * ga[0]; x[u][i][1] += bfhi(mv[u][i].x) * r1 * ga[1];
                    x[u][i][2] += bflo(mv[u][i].y) * r1 * ga[2]; x[u][i][3] += bfhi(mv[u][i].y) * r1 * ga[3];
                }
            }
            float s2 = 0.f;
#pragma unroll
            for (int i = 0; i < 4; ++i) s2 += x[u][i][0] * x[u][i][0] + x[u][i][1] * x[u][i][1] + x[u][i][2] * x[u][i][2] + x[u][i][3] * x[u][i][3];
            s2 = wave_sum(s2);
            const float r2 = rsqrtf(s2 * (1.0f / 1024.0f) + EPS);
            if (mode == 2) {
                float* dst = nullptr;
                if (g < NTP) { const int b = (int)(g / TT), t = (int)(g % TT); if (t >= NMETA) dst = p.out + O_YP + ((size_t)b * 2048 + (t - NMETA)) * 1024; }
                else dst = p.out + O_YS + (size_t)(g - NTP) * 1024;
                if (dst) {
#pragma unroll
                    for (int i = 0; i < 4; ++i) { const f32x4 gb = *(const f32x4*)(gB + i * 256 + lane * 4); *(f32x4*)(dst + i * 256 + lane * 4) = x[u][i] * r2 * gb; }
                }
            } else {
#pragma unroll
                for (int i = 0; i < 4; ++i) {
                    if (mode != 0) { u32x2 xw; xw.x = pk2(x[u][i][0], x[u][i][1]); xw.y = pk2(x[u][i][2], x[u][i][3]); *(u32x2*)(X + g * 1024 + i * 256 + lane * 4) = xw; }
                    const f32x4 gb = *(const f32x4*)(gB + i * 256 + lane * 4);
                    u32x2 w; w.x = pk2(x[u][i][0] * r2 * gb[0], x[u][i][1] * r2 * gb[1]); w.y = pk2(x[u][i][2] * r2 * gb[2], x[u][i][3] * r2 * gb[3]);
                    *(u32x2*)(H + g * 1024 + i * 256 + lane * 4) = w;
                }
            }
        }
    }
}

DI void kv_item(int tid0, LAS char* shm, const Params& p, int l, int type, int b, int tt) {
    const bf16_t* Z = (const bf16_t*)(p.ws + WS_Z);
    const float* rope = (const float*)(p.ws + WS_ROPE);
    int tid = tid0; asm volatile("" : "+v"(tid));
    const int lane = tid & 63, wv = __builtin_amdgcn_readfirstlane(tid >> 6);
    LAS bf16_t* tl = (LAS bf16_t*)shm;
    const int tbase = type == 1 ? PAST : tt * 64;
    const int nvalid = type == 0 ? min(64, TT - tt * 64) : (type == 1 ? ST_ : 64);
    bf16_t* KB; bf16_t* VT; int vld;
    if (type == 0) { KB = (bf16_t*)(p.ws + WS_KBP) + (size_t)b * TT * 160; VT = (bf16_t*)(p.ws + WS_VTP) + (size_t)b * 128 * VTLD_P; vld = VTLD_P; }
    else { KB = (bf16_t*)(p.ws + WS_KBS) + (size_t)b * SKVP * 160; VT = (bf16_t*)(p.ws + WS_VTS) + (size_t)b * 128 * SKVP; vld = SKVP; }
    __syncthreads();
    float in0[8], in1[8], pe0[8], pe1[8];
#pragma unroll
    for (int u = 0; u < 8; ++u) {
        const int tk = wv + 8 * u;
        in0[u] = 0.f; in1[u] = 0.f; pe0[u] = 0.f; pe1[u] = 0.f;
        if (tk < nvalid) {
            const int key = tbase + tk;
            if (type == 2) {
                const f32x2 c = *(const f32x2*)(p.cache_kv + (((size_t)l * SB + b) * PAST + key) * 128 + lane * 2);
                in0[u] = c[0]; in1[u] = c[1];
                if (lane < 16) { const f32x2 pe = *(const f32x2*)(p.cache_pe + (((size_t)l * SB + b) * PAST + key) * 32 + lane * 2); pe0[u] = pe[0]; pe1[u] = pe[1]; }
            } else {
                const long g = type == 0 ? (long)b * TT + key : (long)NTP + b * ST_ + tk;
                const unsigned zz = *(const unsigned*)(Z + g * ZW + ZC_KV + lane * 2);
                in0[u] = bflo(zz); in1[u] = bfhi(zz);
                if (lane < 16) { pe0[u] = bf2f(Z[g * ZW + ZC_PE + lane]); pe1[u] = bf2f(Z[g * ZW + ZC_PE + 16 + lane]); }
            }
        }
    }
#pragma unroll
    for (int u = 0; u < 8; ++u) {
        const int tk = wv + 8 * u;
        float v0 = 0.f, v1 = 0.f;
        if (tk < nvalid) {
            const int key = tbase + tk;
            if (type == 2) {
                v0 = in0[u]; v1 = in1[u];
                if (lane < 16) *(unsigned*)(KB + (size_t)key * 160 + 128 + lane * 2) = pk2(pe0[u], pe1[u]);
            } else {
                const long g = type == 0 ? (long)b * TT + key : (long)NTP + b * ST_ + tk;
                const float a0 = in0[u], a1 = in1[u];
                const float ss = wave_sum(a0 * a0 + a1 * a1);
                const float r = rsqrtf(ss * (1.0f / 128.0f) + EPS);
                const f32x2 gn = *(const f32x2*)(p.kv_norm + l * 128 + lane * 2);
                v0 = a0 * r * gn[0]; v1 = a1 * r * gn[1];
                float* okv = type == 0 ? p.out + O_PKV + (((size_t)l * NB + b) * TT + key) * 128 : p.out + O_SKV + (((size_t)l * SB + b) * ST_ + tk) * 128;
                *(f32x2*)(okv + lane * 2) = (f32x2){v0, v1};
                if (lane < 16) {
                    const float x1 = pe0[u], x2 = pe1[u];
                    const f32x2 cs = *(const f32x2*)(rope + (size_t)pos_index(g) * 32 + lane * 2);
                    const float o1 = x1 * cs[0] - x2 * cs[1], o2 = x1 * cs[1] + x2 * cs[0];
                    float* ope = type == 0 ? p.out + O_PPE + (((size_t)l * NB + b) * TT + key) * 32 : p.out + O_SPE + (((size_t)l * SB + b) * ST_ + tk) * 32;
                    ope[lane] = o1; ope[16 + lane] = o2;
                    KB[(size_t)key * 160 + 128 + lane] = f2bf(o1); KB[(size_t)key * 160 + 144 + lane] = f2bf(o2);
                }
            }
            *(unsigned*)(KB + (size_t)key * 160 + lane * 2) = pk2(v0, v1);
        }
        *(LAS unsigned*)(tl + tk * 130 + lane * 2) = pk2(v0, v1);
    }
    __syncthreads();
    {
        const int dv = tid >> 2, part = tid & 3;
        unsigned w[8];
#pragma unroll
        for (int e = 0; e < 8; ++e) w[e] = (unsigned)tl[(part * 16 + 2 * e) * 130 + dv] | ((unsigned)tl[(part * 16 + 2 * e + 1) * 130 + dv] << 16);
        bf16_t* dst = VT + (size_t)dv * vld + tbase + part * 16;
        *(u32x4*)dst = (u32x4){w[0], w[1], w[4], w[5]};
        *(u32x4*)(dst + 8) = (u32x4){w[2], w[3], w[6], w[7]};
    }
}

#define MFMA32(a, b, c) __builtin_amdgcn_mfma_f32_32x32x16_bf16((a), (b), (c), 0, 0, 0)
constexpr int KSTR = 168, VSTR = 72;
constexpr int ATT_KB = 64 * KSTR * 2, ATT_VB = 128 * VSTR * 2, ATT_BUF = ATT_KB + ATT_VB;
DI void attn_item(int tid0, LAS char* shm, LAS char* shm2, const Params& p, int item) {
    int tid = tid0; asm volatile("" : "+v"(tid));
    const int lane = tid & 63, w = __builtin_amdgcn_readfirstlane(tid >> 6), r = lane & 31, h = lane >> 5;
    bf16_t* QL = (bf16_t*)(p.ws + WS_QL); const bf16_t* QP = (const bf16_t*)(p.ws + WS_QP);
    long rowbase; int nq, kmax, vld; const bf16_t* KB; const bf16_t* VT;
    if (item < SB) {
        const int b = item; rowbase = NTP + b * ST_; nq = ST_; kmax = SKV; vld = SKVP;
        KB = (const bf16_t*)(p.ws + WS_KBS) + (size_t)b * SKVP * 160; VT = (const bf16_t*)(p.ws + WS_VTS) + (size_t)b * 128 * SKVP;
    } else {
        const int a = item - SB, qblk = 64 - a / NB, b = a % NB;
        const int q0 = qblk == 0 ? 0 : 16 + 32 * (qblk - 1);
        nq = qblk == 0 ? 16 : 32; kmax = qblk == 0 ? 16 : 80 + 64 * ((qblk - 1) >> 1); vld = VTLD_P;
        rowbase = (long)b * TT + q0;
        KB = (const bf16_t*)(p.ws + WS_KBP) + (size_t)b * TT * 160; VT = (const bf16_t*)(p.ws + WS_VTP) + (size_t)b * 128 * VTLD_P;
    }
    const int ntiles = (kmax + 63) >> 6;
    const long qrow = rowbase + min(r, nq - 1);
    bf16x8 qf[10];
#pragma unroll
    for (int ks = 0; ks < 8; ++ks) qf[ks] = *(const bf16x8*)(QL + qrow * 1024 + w * 128 + 16 * ks + 8 * h);
#pragma unroll
    for (int ks = 0; ks < 2; ++ks) qf[8 + ks] = *(const bf16x8*)(QP + qrow * 256 + w * 32 + 16 * ks + 8 * h);
    f32x16 O[4];
#pragma unroll
    for (int d = 0; d < 4; ++d)
#pragma unroll
        for (int i = 0; i < 16; ++i) O[d][i] = 0.f;
    float mrun = -INFINITY, lrun = 0.f;
    u32x4 kreg[3], vreg[2];
    const u32x4 zero4 = {0u, 0u, 0u, 0u};
#define ATT_LOAD(t0) do { _Pragma("unroll") for (int i = 0; i < 3; ++i) { const int c = tid + 512 * i; const int key = (t0) + c / 20; \
            kreg[i] = (c < 1280 && key < kmax) ? *(const u32x4*)(KB + (size_t)(t0) * 160 + (size_t)c * 8) : zero4; } \
        _Pragma("unroll") for (int i = 0; i < 2; ++i) { const int c = tid + 512 * i; const int dv = c >> 3, part = c & 7; \
            vreg[i] = ((t0) + part * 8 < kmax) ? *(const u32x4*)(VT + (size_t)dv * vld + (t0) + part * 8) : zero4; } } while (0)
#define ATT_VPTR(j) ((j) == 0 ? (shm + 2 * ATT_KB) : (shm2 + ((j) - 1) * ATT_VB))
#define ATT_STORE(kbuf, vj) do { LAS char* kb_ = shm + (kbuf) * ATT_KB; LAS char* vb_ = ATT_VPTR(vj); \
        _Pragma("unroll") for (int i = 0; i < 3; ++i) { const int c = tid + 512 * i; if (c < 1280) *(LAS u32x4*)(kb_ + ((c / 20) * KSTR + (c % 20) * 8) * 2) = kreg[i]; } \
        _Pragma("unroll") for (int i = 0; i < 2; ++i) { const int c = tid + 512 * i; *(LAS u32x4*)(vb_ + ((c >> 3) * VSTR + (c & 7) * 8) * 2) = vreg[i]; } } while (0)
    const bool grpB = w >= 4;
    bf16x8 pf[2][2];
    float alpha_p = 1.0f;
    auto qk_sm = [&](const LAS bf16_t* Ks, const int t0, const bool last) __attribute__((always_inline)) -> float {
        f32x16 s0, s1;
#pragma unroll
        for (int i = 0; i < 16; ++i) { s0[i] = 0.f; s1[i] = 0.f; }
#pragma unroll
        for (int ks = 0; ks < 10; ++ks) {
            const bf16x8 a0 = *(const LAS bf16x8*)(Ks + r * KSTR + 16 * ks + 8 * h);
            const bf16x8 a1 = *(const LAS bf16x8*)(Ks + (32 + r) * KSTR + 16 * ks + 8 * h);
            s0 = MFMA32(a0, qf[ks], s0); s1 = MFMA32(a1, qf[ks], s1);
        }
        if (last) {
#pragma unroll
            for (int i = 0; i < 16; ++i) {
                const int key = t0 + (i & 3) + 8 * (i >> 2) + 4 * h;
                if (key >= kmax) s0[i] = -INFINITY;
                if (key + 32 >= kmax) s1[i] = -INFINITY;
            }
        }
        float mx = s0[0];
#pragma unroll
        for (int i = 1; i < 16; ++i) mx = fmaxf(mx, s0[i]);
#pragma unroll
        for (int i = 0; i < 16; ++i) mx = fmaxf(mx, s1[i]);
        mx = fmaxf(mx, __shfl_xor(mx, 32));
        const float mnew = fmaxf(mrun, mx);
        const float alpha = __builtin_amdgcn_exp2f(mrun - mnew);
        mrun = mnew;
        float ls = 0.f;
#pragma unroll
        for (int i = 0; i < 16; ++i) { s0[i] = __builtin_amdgcn_exp2f(s0[i] - mnew); s1[i] = __builtin_amdgcn_exp2f(s1[i] - mnew); ls += s0[i] + s1[i]; }
        lrun = lrun * alpha + ls;
#pragma unroll
        for (int s = 0; s < 2; ++s) {
            u32x4 a = {pk2(s0[8 * s], s0[8 * s + 1]), pk2(s0[8 * s + 2], s0[8 * s + 3]), pk2(s0[8 * s + 4], s0[8 * s + 5]), pk2(s0[8 * s + 6], s0[8 * s + 7])};
            u32x4 bq = {pk2(s1[8 * s], s1[8 * s + 1]), pk2(s1[8 * s + 2], s1[8 * s + 3]), pk2(s1[8 * s + 4], s1[8 * s + 5]), pk2(s1[8 * s + 6], s1[8 * s + 7])};
            pf[0][s] = __builtin_bit_cast(bf16x8, a); pf[1][s] = __builtin_bit_cast(bf16x8, bq);
        }
        return alpha;
    };
    auto pv = [&](const LAS bf16_t* Vs, const float alpha) __attribute__((always_inline)) {
        if (__builtin_amdgcn_ballot_w64(alpha != 1.0f) != 0ull) {
#pragma unroll
            for (int d = 0; d < 4; ++d)
#pragma unroll
                for (int i = 0; i < 16; ++i) O[d][i] *= alpha;
        }
#pragma unroll
        for (int d = 0; d < 4; ++d)
#pragma unroll
            for (int kb = 0; kb < 2; ++kb)
#pragma unroll
                for (int s = 0; s < 2; ++s) {
                    const bf16x8 va = *(const LAS bf16x8*)(Vs + (32 * d + r) * VSTR + 32 * kb + 16 * s + 8 * h);
                    O[d] = MFMA32(va, pf[kb][s], O[d]);
                }
    };
    __syncthreads();
    ATT_LOAD(0); ATT_STORE(0, 0); __syncthreads();
    int vj = 0;
    for (int t = 0; t < ntiles; ++t) {
        const int t0 = t * 64;
        if (t + 1 < ntiles) ATT_LOAD(t0 + 64);
        const LAS bf16_t* Ks = (const LAS bf16_t*)(shm + (t & 1) * ATT_KB);
        const int vprev = vj == 0 ? 2 : vj - 1, vnext = vj == 2 ? 0 : vj + 1;
        if (grpB && t > 0) pv((const LAS bf16_t*)ATT_VPTR(vprev), alpha_p);
        alpha_p = qk_sm(Ks, t0, t == ntiles - 1);
        if (!grpB) pv((const LAS bf16_t*)ATT_VPTR(vj), alpha_p);
        if (t + 1 < ntiles) ATT_STORE((t + 1) & 1, vnext);
        __syncthreads();
        vj = vnext;
    }
    if (grpB) { const int vl = vj == 0 ? 2 : vj - 1; pv((const LAS bf16_t*)ATT_VPTR(vl), alpha_p); }
#undef ATT_LOAD
#undef ATT_STORE
#undef ATT_VPTR
    const float ltot = lrun + __shfl_xor(lrun, 32);
    const float inv = 1.0f / ltot;
    if (r < nq) {
        bf16_t* dst = QL + (rowbase + r) * 1024 + w * 128;
#pragma unroll
        for (int d = 0; d < 4; ++d)
#pragma unroll
            for (int g4 = 0; g4 < 4; ++g4) {
                u32x2 wv; wv.x = pk2(O[d][4 * g4] * inv, O[d][4 * g4 + 1] * inv); wv.y = pk2(O[d][4 * g4 + 2] * inv, O[d][4 * g4 + 3] * inv);
                *(u32x2*)(dst + 32 * d + 8 * g4 + 4 * h) = wv;
            }
    }
}

#define MFMA16(a, b, c) __builtin_amdgcn_mfma_f32_16x16x32_bf16((a), (b), (c), 0, 0, 0)
constexpr int SC_QG = 0, SC_KG = 8704, SC_KET = 17408, SC_VT = 27648;
constexpr int SC_ST = 0, SC_AL = 34816, SC_DEC = 37376, SC_PART = 37888, SC_OL = 39936;
DI void scan_item(int tid0, LAS char* shm, LAS char* shm2, const Params& p, int l, int item) {
    int tid = tid0; asm volatile("" : "+v"(tid));
    const int lane = tid & 63, w = __builtin_amdgcn_readfirstlane(tid >> 6), fr = lane & 15, fq = lane >> 4;
    bf16_t* Z = (bf16_t*)(p.ws + WS_Z);
    const bool isS = item >= NB * 4;
    const int b = isS ? (item - NB * 4) >> 2 : item >> 2, hd = item & 3;
    const long row0 = isS ? (long)NTP + b * ST_ : (long)b * TT;
    const int Tn = isS ? ST_ : TT;
    float* Sout = isS ? p.out + O_SS + ((size_t)(l * SB + b) * 4 + hd) * 16384 : p.out + O_PS + ((size_t)(l * NB + b) * 4 + hd) * 16384;
    LAS bf16_t* qG = (LAS bf16_t*)(shm + SC_QG); LAS bf16_t* kg = (LAS bf16_t*)(shm + SC_KG); LAS bf16_t* keT = (LAS bf16_t*)(shm + SC_KET);
    LAS bf16_t* vT = (LAS bf16_t*)(shm + SC_VT); LAS bf16_t* STl = (LAS bf16_t*)(shm2 + SC_ST); LAS bf16_t* Al = (LAS bf16_t*)(shm2 + SC_AL);
    LAS float* dec = (LAS float*)(shm2 + SC_DEC); LAS float* part = (LAS float*)(shm2 + SC_PART); LAS float* ol = (LAS float*)(shm2 + SC_OL);
    const int col = tid & 127, tq = tid >> 7;
    const float lbv = l == 0 ? 0.f : ((const float*)(p.ws + WS_LB))[hd * 128 + col];
    const float oml = 1.0f - lbv;
    f32x4 S[8];
#pragma unroll
    for (int kb = 0; kb < 8; ++kb)
#pragma unroll
        for (int j = 0; j < 4; ++j) S[kb][j] = isS ? p.state_hgrn[(((size_t)(l * SB + b) * 4 + hd) * 128 + 16 * kb + 4 * fq + j) * 128 + 16 * w + fr] : 0.f;
    __syncthreads();
#pragma unroll
    for (int kb = 0; kb < 8; ++kb) { u32x2 wv; wv.x = pk2(S[kb][0], S[kb][1]); wv.y = pk2(S[kb][2], S[kb][3]); *(LAS u32x2*)(STl + (16 * w + fr) * 136 + 16 * kb + 4 * fq) = wv; }
    const int nch = (Tn + 31) >> 5;
    bf16_t rq0[8], rf0[8], rv0[8], rq1[8], rf1[8], rv1[8]; u32x4 hg0, hg1;
#define SC_FETCH(t0, RQ, RF, RV) do { _Pragma("unroll") for (int i = 0; i < 8; ++i) { const int t = (t0) + 8 * tq + i; const bool ok = t < Tn; const bf16_t* zr = Z + (row0 + (ok ? t : 0)) * ZW + hd * 128 + col; \
        RQ[i] = ok ? zr[ZC_HQ] : (bf16_t)0; RF[i] = ok ? zr[ZC_HF] : (bf16_t)0; RV[i] = ok ? zr[ZC_HI] : (bf16_t)0; } } while (0)
#define SC_HG(t0) (((t0) + otok < Tn) ? *(const u32x4*)(Z + (row0 + (t0) + otok) * ZW + ZC_HG + hd * 128 + opart * 8) : (u32x4){0u, 0u, 0u, 0u})
    const int otok = tid >> 4, opart = tid & 15;
    const f32x4 gn0 = *(const f32x4*)(p.hg_on + l * 128 + opart * 8), gn1 = *(const f32x4*)(p.hg_on + l * 128 + opart * 8 + 4);
    SC_FETCH(0, rq0, rf0, rv0); hg0 = SC_HG(0);
    SC_FETCH(32, rq1, rf1, rv1); hg1 = SC_HG(32);
    auto step = [&](const int c, bf16_t (&rq)[8], bf16_t (&rf)[8], bf16_t (&rv)[8], u32x4& hgv) __attribute__((always_inline)) {
        const int t0 = c * 32;
        float cum[8], qq[8], kk[8];
        float run = 0.f;
#pragma unroll
        for (int i = 0; i < 8; ++i) {
            const bool ok = t0 + 8 * tq + i < Tn;
            const float zq = bf2f(rq[i]), zf = bf2f(rf[i]);
            const float sg = sigmoidf_(zf);
            const float f = lbv + oml * sg;
            run += ok ? __logf(f) : 0.f;
            cum[i] = run;
            kk[i] = ok ? oml * (1.0f - sg) : 0.f;
            qq[i] = ok ? siluf_(zq) : 0.f;
        }
        part[tq * 128 + col] = run;
        __syncthreads();
        float pre = 0.f, tot = 0.f;
#pragma unroll
        for (int q = 0; q < 4; ++q) { const float pv = part[q * 128 + col]; tot += pv; if (q < tq) pre += pv; }
        float ke[8];
#pragma unroll
        for (int i = 0; i < 8; ++i) {
            const int tk = 8 * tq + i;
            const float Gi = pre + cum[i];
            qG[tk * 136 + col] = f2bf(qq[i] * __expf(Gi));
            kg[tk * 136 + col] = f2bf(kk[i] * __expf(-fmaxf(Gi, -80.f)));
            ke[i] = kk[i] * __expf(tot - Gi);
        }
        *(LAS u32x4*)(keT + col * 40 + 8 * tq) = (u32x4){pk2(ke[0], ke[1]), pk2(ke[2], ke[3]), pk2(ke[4], ke[5]), pk2(ke[6], ke[7])};
        *(LAS u32x4*)(vT + col * 40 + 8 * tq) = (u32x4){(unsigned)rv[0] | ((unsigned)rv[1] << 16), (unsigned)rv[2] | ((unsigned)rv[3] << 16),
                                                       (unsigned)rv[4] | ((unsigned)rv[5] << 16), (unsigned)rv[6] | ((unsigned)rv[7] << 16)};
        if (tq == 0) dec[col] = __expf(tot);
        __syncthreads();
        if (c + 2 < nch) SC_FETCH(t0 + 64, rq, rf, rv);
        const bool ook = t0 + otok < Tn;
        if (w < 4) {
            const int tb = w >> 1, sb = w & 1;
            f32x4 a = {0.f, 0.f, 0.f, 0.f};
            if (!(tb == 0 && sb == 1)) {
#pragma unroll
                for (int ks = 0; ks < 4; ++ks) {
                    const bf16x8 aq = *(const LAS bf16x8*)(qG + (16 * tb + fr) * 136 + 32 * ks + 8 * fq);
                    const bf16x8 bk = *(const LAS bf16x8*)(kg + (16 * sb + fr) * 136 + 32 * ks + 8 * fq);
                    a = MFMA16(aq, bk, a);
                }
            }
#pragma unroll
            for (int j = 0; j < 4; ++j) { const int t = 16 * tb + 4 * fq + j, s = 16 * sb + fr; Al[t * 40 + s] = f2bf(t >= s ? a[j] : 0.f); }
        }
        f32x4 oa[2] = {{0.f, 0.f, 0.f, 0.f}, {0.f, 0.f, 0.f, 0.f}};
#pragma unroll
        for (int ks = 0; ks < 4; ++ks) {
            const bf16x8 bs = *(const LAS bf16x8*)(STl + (16 * w + fr) * 136 + 32 * ks + 8 * fq);
#pragma unroll
            for (int tb = 0; tb < 2; ++tb) {
                const bf16x8 aq = *(const LAS bf16x8*)(qG + (16 * tb + fr) * 136 + 32 * ks + 8 * fq);
                oa[tb] = MFMA16(aq, bs, oa[tb]);
            }
        }
        __syncthreads();
        const bf16x8 bv = *(const LAS bf16x8*)(vT + (16 * w + fr) * 40 + 8 * fq);
#pragma unroll
        for (int tb = 0; tb < 2; ++tb) {
            const bf16x8 aa = *(const LAS bf16x8*)(Al + (16 * tb + fr) * 40 + 8 * fq);
            oa[tb] = MFMA16(aa, bv, oa[tb]);
        }
#pragma unroll
        for (int kb = 0; kb < 8; ++kb) {
            const f32x4 dv = *(const LAS f32x4*)(dec + 16 * kb + 4 * fq);
            const bf16x8 ak = *(const LAS bf16x8*)(keT + (16 * kb + fr) * 40 + 8 * fq);
            S[kb] = S[kb] * dv;
            S[kb] = MFMA16(ak, bv, S[kb]);
            u32x2 wv; wv.x = pk2(S[kb][0], S[kb][1]); wv.y = pk2(S[kb][2], S[kb][3]);
            *(LAS u32x2*)(STl + (16 * w + fr) * 136 + 16 * kb + 4 * fq) = wv;
        }
#pragma unroll
        for (int tb = 0; tb < 2; ++tb)
#pragma unroll
            for (int j = 0; j < 4; ++j) ol[(16 * tb + 4 * fq + j) * 132 + 16 * w + fr] = oa[tb][j];
        __syncthreads();
        {
            const f32x4 o0 = *(const LAS f32x4*)(ol + otok * 132 + opart * 8), o1 = *(const LAS f32x4*)(ol + otok * 132 + opart * 8 + 4);
            float ss = o0[0] * o0[0] + o0[1] * o0[1] + o0[2] * o0[2] + o0[3] * o0[3] + o1[0] * o1[0] + o1[1] * o1[1] + o1[2] * o1[2] + o1[3] * o1[3];
            ss += __shfl_xor(ss, 1); ss += __shfl_xor(ss, 2); ss += __shfl_xor(ss, 4); ss += __shfl_xor(ss, 8);
            const float rr = rsqrtf(ss * (1.0f / 128.0f) + EPS);
            if (ook) {
                u32x4 wv;
                wv.x = pk2(o0[0] * rr * gn0[0] * siluf_(bflo(hgv.x)), o0[1] * rr * gn0[1] * siluf_(bfhi(hgv.x)));
                wv.y = pk2(o0[2] * rr * gn0[2] * siluf_(bflo(hgv.y)), o0[3] * rr * gn0[3] * siluf_(bfhi(hgv.y)));
                wv.z = pk2(o1[0] * rr * gn1[0] * siluf_(bflo(hgv.z)), o1[1] * rr * gn1[1] * siluf_(bfhi(hgv.z)));
                wv.w = pk2(o1[2] * rr * gn1[2] * siluf_(bflo(hgv.w)), o1[3] * rr * gn1[3] * siluf_(bfhi(hgv.w)));
                *(u32x4*)(Z + (row0 + t0 + otok) * ZW + ZC_HI + hd * 128 + opart * 8) = wv;
            }
        }
        if (c + 2 < nch) hgv = SC_HG(t0 + 64);
    };
    for (int c = 0; c < nch; c += 2) {
        step(c, rq0, rf0, rv0, hg0);
        if (c + 1 < nch) step(c + 1, rq1, rf1, rv1, hg1);
    }
#undef SC_HG
#undef SC_FETCH
#pragma unroll
    for (int kb = 0; kb < 8; ++kb)
#pragma unroll
        for (int j = 0; j < 4; ++j) Sout[(size_t)(16 * kb + 4 * fq + j) * 128 + 16 * w + fr] = S[kb][j];
}

constexpr int N_PH = 1 + 2 * 8;

template <int ph>
DI void run_phase(const Params& pp, LAS char* shm, LAS char* shm2, int* s_item_p) {
#define s_item (*s_item_p)
        Params p = pp;
        asm volatile("" : "+s"(p.ws), "+s"(p.out));
        int tid = threadIdx.x; asm volatile("" : "+v"(tid));
        int bid = blockIdx.x; asm volatile("" : "+s"(bid));
        bf16_t* H = (bf16_t*)(p.ws + WS_H); bf16_t* Z = (bf16_t*)(p.ws + WS_Z); bf16_t* QL = (bf16_t*)(p.ws + WS_QL); bf16_t* QP = (bf16_t*)(p.ws + WS_QP);
        bf16_t* G = (bf16_t*)(p.ws + WS_G); float* RS = (float*)(p.ws + WS_RS);
        if (ph == 0) {
          if (PHMASK & 1) {
            prep_weights(tid, bid, p);
            rows_phase(tid, bid, p, 0, nullptr, p.n_mix_pre);
          }
        } else {
            const int l = (ph - 1) >> 3, sp = (ph - 1) & 7;
            if (sp == 0 && (PHMASK & 2)) {
                const bf16_t* W = (const bf16_t*)(p.ws + WS_WIN) + (size_t)l * ZW * 1024;
                const GemmA ga{H, 1024, nullptr, 0, 1 << 30};
                auto rm = [](int pm, int R) { return pm * 256 + R; };
                const EpiZ epi{Z, RS};
                gemm_phase<false>(tid, bid, (const unsigned*)(p.ws + WS_CNT), shm, shm2, ga, rm, W, 1024, 259, 10, epi);
            } else if (sp == 1 && (PHMASK & 4)) {
                const int nkv = NB * 33 + SB + SB * 64;
                for (int it = bid; it < nkv; it += gridDim.x) {
                    if (it < NB * 33) kv_item(tid, shm, p, l, 0, it / 33, it % 33);
                    else if (it < NB * 33 + SB) kv_item(tid, shm, p, l, 1, it - NB * 33, 0);
                    else { const int a = it - NB * 33 - SB; kv_item(tid, shm, p, l, 2, a >> 6, a & 63); }
                }
                const GemmA ga{Z, ZW, nullptr, 0, 1 << 30};
                auto rm = [](int pm, int R) { return pm * 256 + R; };
                const EpiQ epi{QL, QP, (const float*)(p.ws + WS_ROPE), RS};
                gemm_phase<false>(tid, bid, (const unsigned*)(p.ws + WS_CNT), shm, shm2, ga, rm, (const bf16_t*)(p.ws + WS_WQ) + (size_t)l * 1280 * 256, 256, 259, 5, epi);
            } else if (sp == 2 && (PHMASK & 8)) {
                for (int it = bid; it < NB * 4 + SB * 4; it += gridDim.x) scan_item(tid, shm, shm2, p, l, it);
                unsigned* cnt = (unsigned*)(p.ws + WS_CNT) + l;
                __syncthreads();
                if (tid == 0) s_item = (int)atomicAdd(cnt, 1u);
                for (;;) {
                    __syncthreads();
                    const int it = s_item;
                    if (it >= SB + NB * 65) break;
                    __syncthreads();
                    if (tid == 0) s_item = (int)atomicAdd(cnt, 1u);
                    attn_item(tid, shm, shm2, p, it);
                }
            } else if (sp == 3 && (PHMASK & 16)) {
                const bf16_t* W = (const bf16_t*)(p.ws + WS_WO) + (size_t)l * 1024 * 1536;
                const GemmA ga{QL, 1024, Z + ZC_HI, ZW, 1024};
                auto rm = [](int pm, int R) { return pm * 256 + R; };
                const EpiOut epi{H, RS};
                gemm_phase<true>(tid, bid, (const unsigned*)(p.ws + WS_CNT), shm, shm2, ga, rm, W, 1536, 259, 4, epi);
            } else if (sp == 4 && (PHMASK & 32)) {
                rows_phase(tid, bid, p, 1, p.n_mix_post + l * 1024, p.n_ffn_pre + l * 1024, l == 0);
            } else if (sp == 5 && (PHMASK & 64)) {
                const bf16_t* W = (const bf16_t*)(p.ws + WS_WUP) + (size_t)l * 5632 * 1024;
                const GemmA ga{H, 1024, nullptr, 0, 1 << 30};
                auto rm = [](int pm, int R) -> int {
                    const int st = 2 * pm + (R >> 7), lr = R & 127;
                    if (st < NSUBP) { const int gg = 126 * st - 2 + lr; return (gg >= 0 && gg < NTP) ? gg : ZROW; }
                    if (st == NSUBP) return NTP + lr;
                    return ZROW;
                };
                const EpiUp epi{G, p.conv_w, p.conv_b, p.state_conv, p.out, l};
                gemm_phase<false>(tid, bid, (const unsigned*)(p.ws + WS_CNT), shm, shm2, ga, rm, W, 1024, NMUP, 22, epi);
            } else if (sp == 6 && (PHMASK & 128)) {
                const bf16_t* W = (const bf16_t*)(p.ws + WS_WD) + (size_t)l * 1024 * DFF;
                const GemmA ga{G, DFF, nullptr, 0, 1 << 30};
                auto rm = [](int pm, int R) { return pm * 256 + R; };
                const EpiOut epi{H, RS};
                gemm_phase<false>(tid, bid, (const unsigned*)(p.ws + WS_CNT), shm, shm2, ga, rm, W, DFF, 259, 4, epi);
            } else if (PHMASK & 256) {
                if (l == 0) rows_phase(tid, bid, p, 1, p.n_ffn_post, p.n_mix_pre + 1024);
                else rows_phase(tid, bid, p, 2, p.n_ffn_post + 1024, p.final_norm);
            }
        }
#undef s_item
}

DI void grid_barrier(unsigned* cnt, unsigned k, int bid) {
    asm volatile("s_waitcnt vmcnt(0)" ::: "memory");
    __syncthreads();
    if (threadIdx.x == 0) {
        const unsigned xcc = cnt[64 + bid] >> 16;
        unsigned cx = 0, nx = 0;
#pragma unroll
        for (unsigned x = 0; x < 8; ++x) { const unsigned c = __hip_atomic_load(cnt + 16 + x, __ATOMIC_RELAXED, __HIP_MEMORY_SCOPE_AGENT); nx += c != 0u; cx = x == xcc ? c : cx; }
        const unsigned old = __hip_atomic_fetch_add(cnt + 24 + xcc, 1u, __ATOMIC_RELAXED, __HIP_MEMORY_SCOPE_AGENT);
        if (old + 1u == k * cx) {
            __builtin_amdgcn_fence(__ATOMIC_RELEASE, "agent");
            asm volatile("s_waitcnt vmcnt(0)" ::: "memory");
            __hip_atomic_fetch_add(cnt + 48, 1u, __ATOMIC_RELAXED, __HIP_MEMORY_SCOPE_AGENT);
        }
        while (__hip_atomic_load(cnt + 48, __ATOMIC_RELAXED, __HIP_MEMORY_SCOPE_AGENT) < k * nx) __builtin_amdgcn_s_sleep(48);
        __builtin_amdgcn_fence(__ATOMIC_ACQUIRE, "agent");
        asm volatile("s_waitcnt vmcnt(0)" ::: "memory");
    }
    __syncthreads();
}

template <int ph>
DI void phase_step(const Params& pp, LAS char* shm, LAS char* shm2, int* s_item_p) {
    if (ph >= pp.ph_lo && ph < pp.ph_hi) {
        run_phase<ph>(pp, shm, shm2, s_item_p);
        if ((REPMASK >> ph) & 1) { cg::this_grid().sync(); run_phase<ph>(pp, shm, shm2, s_item_p); }
        if (ph + 1 < pp.ph_hi) {
            if (ph == 0) cg::this_grid().sync();
            else grid_barrier((unsigned*)(pp.ws + WS_CNT), (unsigned)ph, (int)blockIdx.x);
        }
    }
}

__global__ void __launch_bounds__(512, 2) fwd_kernel(Params pp) {
    __shared__ __attribute__((aligned(1024))) char shm_raw[STAGE_B];
    __shared__ __attribute__((aligned(1024))) char shm_raw2[STAGE_B];
    __shared__ int s_item_v;
    LAS char* shm = (LAS char*)shm_raw; LAS char* shm2 = (LAS char*)shm_raw2;
    phase_step<0>(pp, shm, shm2, &s_item_v); phase_step<1>(pp, shm, shm2, &s_item_v); phase_step<2>(pp, shm, shm2, &s_item_v); phase_step<3>(pp, shm, shm2, &s_item_v);
    phase_step<4>(pp, shm, shm2, &s_item_v); phase_step<5>(pp, shm, shm2, &s_item_v); phase_step<6>(pp, shm, shm2, &s_item_v); phase_step<7>(pp, shm, shm2, &s_item_v);
    phase_step<8>(pp, shm, shm2, &s_item_v); phase_step<9>(pp, shm, shm2, &s_item_v); phase_step<10>(pp, shm, shm2, &s_item_v); phase_step<11>(pp, shm, shm2, &s_item_v);
    phase_step<12>(pp, shm, shm2, &s_item_v); phase_step<13>(pp, shm, shm2, &s_item_v); phase_step<14>(pp, shm, shm2, &s_item_v); phase_step<15>(pp, shm, shm2, &s_item_v);
    phase_step<16>(pp, shm, shm2, &s_item_v);
}

extern "C" void kernel_launch(void* const* d_in, const int* in_sizes, int n_in, void* d_out, int out_size, void* d_ws, size_t ws_size, hipStream_t stream) {
    static int grid = 0;
    if (grid == 0) {
        if (ws_size < WS_END) { fprintf(stderr, "kernel_launch: workspace too small: %zu < %zu\n", ws_size, (size_t)WS_END); grid = -1; return; }
        int dev = 0, cus = 0, per_cu = 0;
        hipGetDevice(&dev);
        hipDeviceGetAttribute(&cus, hipDeviceAttributeMultiprocessorCount, dev);
        hipOccupancyMaxActiveBlocksPerMultiprocessor(&per_cu, fwd_kernel, 512, 0);
        if (per_cu < 1) { fprintf(stderr, "kernel_launch: occupancy query says %d blocks/CU\n", per_cu); per_cu = 1; }
        grid = cus * 1;
    }
    if (grid < 0) return;
    if (hipMemsetAsync((char*)d_ws + WS_CNT, 0, 256, stream) != hipSuccess) { fprintf(stderr, "memset failed\n"); return; }
    Params p{};
    const float** f = (const float**)&p;
    for (int i = 0; i < 25; ++i) f[i] = (const float*)d_in[i];
    p.out = (float*)d_out; p.ws = (char*)d_ws;
#if MULTI
    for (int ph = 0; ph < N_PH; ++ph) {
        p.ph_lo = ph; p.ph_hi = ph + 1;
        hipLaunchKernelGGL(fwd_kernel, dim3(grid), dim3(512), 0, stream, p);
    }
#else
    p.ph_lo = 0; p.ph_hi = N_PH;
    void* args[] = {&p};
    hipError_t e = hipLaunchCooperativeKernel((void*)fwd_kernel, dim3(grid), dim3(512), args, 0, stream);
    if (e != hipSuccess) fprintf(stderr, "cooperative launch failed: %s (grid %d)\n", hipGetErrorString(e), grid);
#endif
}
```

```cpp
#include <hip/hip_runtime.h>
#include <hip/hip_cooperative_groups.h>
#include <cstdio>
namespace cg = cooperative_groups;

#ifndef PHMASK
#define PHMASK 0x1ff
#endif
#ifndef REPMASK
#define REPMASK 0
#endif
#ifndef MULTI
#define MULTI 0
#endif

#define LAS __attribute__((address_space(3)))
#define DI __device__ __forceinline__
typedef unsigned short bf16_t;
typedef short bf16x8 __attribute__((ext_vector_type(8)));
typedef short s16x4 __attribute__((ext_vector_type(4)));
typedef float f32x4 __attribute__((ext_vector_type(4)));
typedef float f32x2 __attribute__((ext_vector_type(2)));
typedef float f32x16 __attribute__((ext_vector_type(16)));
typedef unsigned u32x4 __attribute__((ext_vector_type(4)));
typedef unsigned u32x2 __attribute__((ext_vector_type(2)));

constexpr int DM = 1024, NB = 32, TT = 2064, NMETA = 16, SB = 8, ST_ = 16, PAST = 4096;
constexpr int NTP = NB * TT;
constexpr int NTOK = NTP + SB * ST_;
constexpr int MP = 66304;
constexpr int ZW = 2560, DFF = 2816, INW = 2464;
constexpr int ZC_KV = 256, ZC_HQ = 384, ZC_HF = 896, ZC_HI = 1408, ZC_HG = 1920, ZC_PE = 2432;
constexpr int SKV = PAST + ST_;
constexpr int SKVP = 4160;
constexpr int VTLD_P = 2112;
constexpr float EPS = 1e-6f;
constexpr int ZROW = MP - 1;
constexpr int NSUBP = (NTP + 125) / 126;
constexpr int NMUP = (NSUBP + 1 + 1) / 2;

constexpr long O_YP = 0, O_YS = 67108864L, O_PKV = 67239936L, O_PPE = 84148224L, O_PS = 88375296L, O_PCONV = 92569600L,
               O_SKV = 92930048L, O_SPE = 92962816L, O_SS = 92971008L, O_SCONV = 94019584L;

constexpr size_t al256(size_t x) { return (x + 255) & ~(size_t)255; }
constexpr size_t WS_X = 0;
constexpr size_t WS_H = WS_X + al256((size_t)MP * 1024 * 4);
constexpr size_t WS_Z = WS_H + al256((size_t)MP * 1024 * 2);
constexpr size_t WS_QL = WS_Z + al256((size_t)MP * ZW * 2);
constexpr size_t WS_QP = WS_QL + al256((size_t)MP * 1024 * 2);
constexpr size_t WS_G = WS_Z;
constexpr size_t WS_KBP = WS_QP + al256((size_t)MP * 256 * 2);
constexpr size_t WS_KBS = WS_KBP + al256((size_t)(NTP + 64) * 160 * 2);
constexpr size_t WS_VTP = WS_KBS + al256((size_t)SB * SKVP * 160 * 2);
constexpr size_t WS_VTS = WS_VTP + al256((size_t)NB * 128 * VTLD_P * 2);
constexpr size_t WS_WIN = WS_VTS + al256((size_t)SB * 128 * SKVP * 2);
constexpr size_t WS_WQ = WS_WIN + al256((size_t)2 * ZW * 1024 * 2);
constexpr size_t WS_WO = WS_WQ + al256((size_t)2 * 1280 * 256 * 2);
constexpr size_t WS_WUP = WS_WO + al256((size_t)2 * 1024 * 1536 * 2);
constexpr size_t WS_WD = WS_WUP + al256((size_t)2 * 5632 * 1024 * 2);
constexpr size_t WS_RS = WS_WD + al256((size_t)2 * 1024 * DFF * 2);
constexpr size_t WS_ROPE = WS_RS + al256((size_t)MP * 16 * 4);
constexpr size_t WS_LB = WS_ROPE + al256((size_t)2080 * 16 * 2 * 4);
constexpr size_t WS_CNT = WS_LB + al256(512 * 4);
constexpr size_t WS_END = WS_CNT + 8192;
static_assert((size_t)MP * DFF * 2 <= (WS_QP - WS_Z), "G overlay");

struct Params {
    const float *x_prompt, *x_sample, *cache_kv, *cache_pe, *state_hgrn, *state_conv, *meta, *w_in, *n_mix_pre, *n_mix_post,
        *q_norm, *kv_norm, *w_uq, *w_uk, *w_uv, *hg_lb, *hg_on, *w_out, *n_ffn_pre, *n_ffn_post, *w_up, *conv_w, *conv_b, *w_down, *final_norm;
    float* out;
    char* ws;
    int ph_lo, ph_hi;
};

DI unsigned pk2(float lo, float hi) {
    typedef __bf16 bf2 __attribute__((ext_vector_type(2)));
    f32x2 v = {lo, hi};
    bf2 r = __builtin_convertvector(v, bf2);
    return __builtin_bit_cast(unsigned, r);
}
DI bf16_t f2bf(float x) { return (bf16_t)(pk2(x, 0.f) & 0xffffu); }
DI float bf2f(bf16_t u) { return __uint_as_float(((unsigned)u) << 16); }
DI float bflo(unsigned u) { return __uint_as_float(u << 16); }
DI float bfhi(unsigned u) { return __uint_as_float(u & 0xffff0000u); }
DI float sigmoidf_(float x) { return 1.0f / (1.0f + __expf(-x)); }
DI float siluf_(float x) { return x / (1.0f + __expf(-x)); }
DI float wave_sum(float v) {
#pragma unroll
    for (int o = 32; o >= 1; o >>= 1) v += __shfl_xor(v, o);
    return v;
}
DI int pos_index(long g) {
    if (g < NTP) return (int)(g % TT);
    long r = g - NTP; if (r >= SB * ST_) r = 0;
    return TT + (int)(r % ST_);
}

constexpr int BK = 64, TILE_B = 256 * BK * 2, STAGE_B = 2 * TILE_B;
DI int lds_byte(int r, int c) {
    int st = (r >> 4) * 2 + (c >> 5), ob = (r & 15) * 64 + (c & 31) * 2;
    return st * 1024 + (ob ^ (((ob >> 9) & 1) << 5));
}
DI void stage_rc(int b, int& R, int& C) {
    int st = b >> 10, sb = b & 1023, swz = sb ^ (((sb >> 9) & 1) << 5);
    R = (st / 2) * 16 + swz / 64;
    C = (st % 2) * 32 + (swz % 64) / 2;
}
#define WAIT_V0() asm volatile("s_waitcnt vmcnt(0)" ::: "memory")

struct GemmA { const bf16_t* p0; long ld0; const bf16_t* p1; long ld1; int K0; };

DI void tile_decode(int v, int nM, int nN, int& pm, int& pn) {
    const int nig = 8 * nN, gid = v / nig, fm = gid * 8, rem = v - gid * nig;
    const int gsz = (nM - fm) < 8 ? (nM - fm) : 8;
    pn = rem / gsz; pm = fm + rem - pn * gsz;
}
template <bool TWO, class RowMap, class Epi>
DI void gemm_phase(int tid0, int bid, const unsigned* cnt, LAS char* shA, LAS char* shB, const GemmA ga, const RowMap& rowmap, const bf16_t* W, int K, int nM, int nN, const Epi& epi) {
    int tid = tid0; asm volatile("" : "+v"(tid));
    const int wid = __builtin_amdgcn_readfirstlane(tid >> 6), wr = wid >> 2, wc = wid & 3;
    const int G = gridDim.x, ntiles = nM * nN;
    int vb;
    {
        const unsigned info = cnt[64 + bid], xcc = info >> 16;
        unsigned pre = 0;
#pragma unroll
        for (unsigned x = 0; x < 8; ++x) { const unsigned c = cnt[16 + x]; pre += x < xcc ? c : 0u; }
        vb = (int)(pre + (info & 0xffffu));
    }
    int v = vb;
    if (v >= ntiles) return;
    int pm, pn; tile_decode(v, nM, nN, pm, pn);
    unsigned offA0[4], offA1[4], offB[4];
#define G_OFFS(PM, PN) do { int lo_ = tid; asm volatile("" : "+v"(lo_)); lo_ &= 63; _Pragma("unroll") for (int i = 0; i < 4; ++i) { int R, C; stage_rc(wid * 1024 + i * 8192 + lo_ * 16, R, C); \
        const unsigned gr = (unsigned)rowmap((PM), R); offA0[i] = gr * (unsigned)ga.ld0 + C; offA1[i] = TWO ? gr * (unsigned)ga.ld1 + C - ga.K0 : 0u; \
        offB[i] = (unsigned)(((PN) * 256 + R) * K + C); } } while (0)
#define G_PIECE(buf, kt, p) do { if ((p) < 4) { \
            const bf16_t* srcA = (!TWO || (kt) * BK < ga.K0) ? (ga.p0 + (offA0[(p) & 3] + (kt) * BK)) : (ga.p1 + (offA1[(p) & 3] + (kt) * BK)); \
            __builtin_amdgcn_global_load_lds((const unsigned*)srcA, (LAS unsigned*)(((buf) ? shB : shA) + wid * 1024 + ((p) & 3) * 8192), 16, 0, 0); \
        } else { \
            __builtin_amdgcn_global_load_lds((const unsigned*)(W + (offB[(p) & 3] + (kt) * BK)), (LAS unsigned*)(((buf) ? shB : shA) + TILE_B + wid * 1024 + ((p) & 3) * 8192), 16, 0, 0); } } while (0)
#define G_STAGE(buf, kt) do { G_PIECE(buf, kt, 0); G_PIECE(buf, kt, 4); G_PIECE(buf, kt, 1); G_PIECE(buf, kt, 5); G_PIECE(buf, kt, 2); G_PIECE(buf, kt, 6); G_PIECE(buf, kt, 3); G_PIECE(buf, kt, 7); } while (0)
    G_OFFS(pm, pn);
    f32x4 acc[8][4];
#pragma unroll
    for (int m = 0; m < 8; ++m)
#pragma unroll
        for (int n = 0; n < 4; ++n) acc[m][n] = (f32x4){0.f, 0.f, 0.f, 0.f};
    const int nt = K / BK;
    __syncthreads();
    G_STAGE(0, 0); WAIT_V0(); __syncthreads();
    for (;;) {
        int pm2 = 0, pn2 = 0; bool more = false;
        int tl = tid; asm volatile("" : "+v"(tl));
        const int lane = tl & 63, fr = lane & 15, fq = lane >> 4;
        const int fo_ = fr * 64 + fq * 16, fo = fo_ ^ (((fo_ >> 9) & 1) << 5);
        const int aoffA = wr * 16384 + fo, aoffB = TILE_B + wc * 8192 + fo;
        const unsigned abase0 = (unsigned)(unsigned long)(shA + aoffA), abase1 = (unsigned)(unsigned long)(shB + aoffA);
        const unsigned bbase0 = (unsigned)(unsigned long)(shA + aoffB), bbase1 = (unsigned)(unsigned long)(shB + aoffB);
#define G_RD(dst, addr, off) asm volatile("ds_read_b128 %0, %1 offset:%2" : "=v"(dst) : "v"(addr), "n"(off))
#define G_MM(m, i, cb) do { _Pragma("unroll") for (int n = 0; n < 4; ++n) \
            asm volatile("v_mfma_f32_16x16x32_bf16 %0, %1, %2, %0" : "+v"(acc[(m)][n]) : "v"(Bq[n]), "v"(Aq[cb][i])); } while (0)
#define G_GROUP(ab, bb, g, WN, nbuf, st, kt) do { \
            if ((g) + 1 < 8) { G_RD(Aq[((g) & 1) ^ 1][0], ab, ((((g) + 1) >> 2) * 1024 + (2 * (((g) + 1) & 3)) * 2048)); \
                               G_RD(Aq[((g) & 1) ^ 1][1], ab, ((((g) + 1) >> 2) * 1024 + (2 * (((g) + 1) & 3) + 1) * 2048)); } \
            if ((g) < 4) { if (st) { G_PIECE(nbuf, kt, (g)); G_PIECE(nbuf, kt, (g) + 4); } } \
            asm volatile("s_waitcnt lgkmcnt(" #WN ")" ::: "memory"); \
            __builtin_amdgcn_s_setprio(1); \
            G_MM(2 * ((g) & 3), 0, (g) & 1); G_MM(2 * ((g) & 3) + 1, 1, (g) & 1); \
            __builtin_amdgcn_s_setprio(0); \
            if ((g) == 3) { asm volatile("s_nop 1"); G_RD(Bq[0], bb, 1024); G_RD(Bq[1], bb, 1024 + 2048); G_RD(Bq[2], bb, 1024 + 4096); G_RD(Bq[3], bb, 1024 + 6144); } \
            __builtin_amdgcn_sched_barrier(0); \
        } while (0)
#define G_COMPUTE(buf, st, kt) do { bf16x8 Bq[4], Aq[2][2]; const unsigned ab = (buf) ? abase1 : abase0, bb = (buf) ? bbase1 : bbase0; \
            G_RD(Bq[0], bb, 0); G_RD(Bq[1], bb, 2048); G_RD(Bq[2], bb, 4096); G_RD(Bq[3], bb, 6144); \
            G_RD(Aq[0][0], ab, 0); G_RD(Aq[0][1], ab, 2048); \
            G_GROUP(ab, bb, 0, 2, (buf) ^ 1, st, kt); G_GROUP(ab, bb, 1, 2, (buf) ^ 1, st, kt); G_GROUP(ab, bb, 2, 2, (buf) ^ 1, st, kt); G_GROUP(ab, bb, 3, 2, (buf) ^ 1, st, kt); \
            G_GROUP(ab, bb, 4, 2, (buf) ^ 1, st, kt); G_GROUP(ab, bb, 5, 2, (buf) ^ 1, st, kt); G_GROUP(ab, bb, 6, 2, (buf) ^ 1, st, kt); G_GROUP(ab, bb, 7, 0, (buf) ^ 1, st, kt); \
            } while (0)
        for (int t = 0; t < nt; t += 2) {
            G_COMPUTE(0, true, t + 1);
            WAIT_V0(); __syncthreads();
            bool st = true; int ktn = t + 2;
            if (t + 2 >= nt) {
                v += G; more = v < ntiles; st = more; ktn = 0;
                if (more) { tile_decode(v, nM, nN, pm2, pn2); G_OFFS(pm2, pn2); }
            }
            G_COMPUTE(1, st, ktn);
            WAIT_V0(); __syncthreads();
        }
#undef G_COMPUTE
#undef G_GROUP
#undef G_MM
#undef G_RD
        asm volatile("s_nop 15\n\ts_nop 7" ::: "memory");
        epi(pm, pn, acc, wr, wc, fr, fq, lane);
        if (!more) break;
        pm = pm2; pn = pn2;
#pragma unroll
        for (int m = 0; m < 8; ++m)
#pragma unroll
            for (int n = 0; n < 4; ++n) acc[m][n] = (f32x4){0.f, 0.f, 0.f, 0.f};
    }
#undef G_STAGE
#undef G_PIECE
#undef G_OFFS
}

struct EpiZ {
    bf16_t* dst; float* rs;
    DI void operator()(int pm, int pn, const f32x4 (&acc)[8][4], int wr, int wc, int fr, int fq, int) const {
#pragma unroll
        for (int m = 0; m < 8; ++m) {
            const long g = (long)pm * 256 + wr * 128 + m * 16 + fr;
            float ss = 0.f;
            if (pn == 0) {
#pragma unroll
                for (int n = 0; n < 4; ++n)
#pragma unroll
                    for (int j = 0; j < 4; ++j) ss += acc[m][n][j] * acc[m][n][j];
                ss += __shfl_xor(ss, 16); ss += __shfl_xor(ss, 32);
            }
            if (g < NTOK) {
                bf16_t* rp = dst + g * ZW + pn * 256 + wc * 64 + fq * 4;
#pragma unroll
                for (int n = 0; n < 4; ++n) { u32x2 w; w.x = pk2(acc[m][n][0], acc[m][n][1]); w.y = pk2(acc[m][n][2], acc[m][n][3]); *(u32x2*)(rp + n * 16) = w; }
                if (pn == 0 && fq == 0) rs[g * 16 + wc] = ss;
            }
            asm volatile("" ::: "memory");
        }
    }
};
struct EpiOut {
    bf16_t* dst; float* rs;
    DI void operator()(int pm, int pn, const f32x4 (&acc)[8][4], int wr, int wc, int fr, int fq, int) const {
#pragma unroll
        for (int m = 0; m < 8; ++m) {
            const long g = (long)pm * 256 + wr * 128 + m * 16 + fr;
            float ss = 0.f;
#pragma unroll
            for (int n = 0; n < 4; ++n)
#pragma unroll
                for (int j = 0; j < 4; ++j) ss += acc[m][n][j] * acc[m][n][j];
            ss += __shfl_xor(ss, 16); ss += __shfl_xor(ss, 32);
            if (g < NTOK) {
                bf16_t* rp = dst + g * 1024 + pn * 256 + wc * 64 + fq * 4;
#pragma unroll
                for (int n = 0; n < 4; ++n) { u32x2 w; w.x = pk2(acc[m][n][0], acc[m][n][1]); w.y = pk2(acc[m][n][2], acc[m][n][3]); *(u32x2*)(rp + n * 16) = w; }
                if (fq == 0) rs[g * 16 + pn * 4 + wc] = ss;
            }
            asm volatile("" ::: "memory");
        }
    }
};
struct EpiQ {
    bf16_t* ql; bf16_t* qp; const float* rope; const float* rs;
    DI void operator()(int pm, int pn, const f32x4 (&acc)[8][4], int wr, int wc, int fr, int fq, int) const {
#pragma unroll
        for (int m = 0; m < 8; ++m) {
            const int lr = wr * 128 + m * 16 + fr;
            const long g = (long)pm * 256 + lr;
            if (g < NTOK) {
                const f32x4 pr = *(const f32x4*)(rs + g * 16);
                const float r = rsqrtf((pr[0] + pr[1] + pr[2] + pr[3]) * (1.0f / 256.0f) + EPS);
                if (pn < 4) {
                    bf16_t* rp = ql + g * 1024 + pn * 256 + wc * 64 + fq * 4;
#pragma unroll
                    for (int n = 0; n < 4; ++n) { u32x2 w; w.x = pk2(acc[m][n][0] * r, acc[m][n][1] * r); w.y = pk2(acc[m][n][2] * r, acc[m][n][3] * r); *(u32x2*)(rp + n * 16) = w; }
                } else {
                    const float* tb = rope + (size_t)pos_index(g) * 32 + fq * 8;
                    const f32x4 c0 = *(const f32x4*)tb, c1 = *(const f32x4*)(tb + 4);
                    const float cs[4] = {c0[0], c0[2], c1[0], c1[2]}, sn[4] = {c0[1], c0[3], c1[1], c1[3]};
#pragma unroll
                    for (int hh = 0; hh < 2; ++hh) {
                        float o1[4], o2[4];
#pragma unroll
                        for (int j = 0; j < 4; ++j) { const float x1 = acc[m][2 * hh][j] * r, x2 = acc[m][2 * hh + 1][j] * r; o1[j] = x1 * cs[j] - x2 * sn[j]; o2[j] = x1 * sn[j] + x2 * cs[j]; }
                        bf16_t* rp = qp + g * 256 + wc * 64 + hh * 32 + fq * 4;
                        u32x2 w; w.x = pk2(o1[0], o1[1]); w.y = pk2(o1[2], o1[3]); *(u32x2*)rp = w;
                        w.x = pk2(o2[0], o2[1]); w.y = pk2(o2[2], o2[3]); *(u32x2*)(rp + 16) = w;
                    }
                }
            }
            asm volatile("" ::: "memory");
        }
    }
};
struct EpiUp {
    bf16_t* G; const float* cw; const float* cb; const float* sconv; float* out; int l;
    DI void operator()(int pm, int pn, const f32x4 (&acc)[8][4], int wr, int wc, int fr, int fq, int lane) const {
        const int st = 2 * pm + wr;
        const bool isP = st < NSUBP, isS = st == NSUBP;
        const int chb = pn * 128 + wc * 32 + fq * 4;
#pragma unroll
        for (int n = 0; n < 2; ++n) {
            const int ch = chb + n * 16;
            const f32x4 w0 = *(const f32x4*)(cw + (size_t)(l * 3 + 0) * DFF + ch), w1 = *(const f32x4*)(cw + (size_t)(l * 3 + 1) * DFF + ch),
                        w2 = *(const f32x4*)(cw + (size_t)(l * 3 + 2) * DFF + ch), bb = *(const f32x4*)(cb + (size_t)l * DFF + ch);
#pragma unroll
            for (int m = 0; m < 8; ++m) {
                f32x4 p1, p2;
#pragma unroll
                for (int j = 0; j < 4; ++j) {
                    const float a = acc[m][n][j];
                    const float am = acc[m > 0 ? m - 1 : 0][n][j];
                    const int ai = __builtin_bit_cast(int, a), ami = __builtin_bit_cast(int, am);
                    const float s1 = __builtin_bit_cast(float, __builtin_amdgcn_update_dpp(0, ai, 0x111, 0xf, 0xf, true));
                    const float s2 = __builtin_bit_cast(float, __builtin_amdgcn_update_dpp(0, ai, 0x112, 0xf, 0xf, true));
                    const float t1 = __builtin_bit_cast(float, __builtin_amdgcn_update_dpp(0, ami, 0x121, 0xf, 0xf, true));
                    const float t2 = __builtin_bit_cast(float, __builtin_amdgcn_update_dpp(0, ami, 0x122, 0xf, 0xf, true));
                    p1[j] = fr >= 1 ? s1 : t1;
                    p2[j] = fr >= 2 ? s2 : t2;
                }
                const int lr = m * 16 + fr;
                if (isP) {
                    const int gg = 126 * st - 2 + lr;
                    if (lr >= 2 && gg < NTP) {
                        const int b = gg / TT, t = gg - b * TT;
                        const long g = gg;
                        if (t < 1) p1 = (f32x4){0.f, 0.f, 0.f, 0.f};
                        if (t < 2) p2 = (f32x4){0.f, 0.f, 0.f, 0.f};
                        f32x4 gv;
#pragma unroll
                        for (int j = 0; j < 4; ++j) { const float c = bb[j] + w0[j] * p2[j] + w1[j] * p1[j] + w2[j] * acc[m][n][j]; gv[j] = siluf_(c) * acc[m][n + 2][j]; }
                        u32x2 w; w.x = pk2(gv[0], gv[1]); w.y = pk2(gv[2], gv[3]);
                        *(u32x2*)(G + g * DFF + ch) = w;
                        if (t >= TT - 2) *(f32x4*)(out + O_PCONV + ((size_t)(l * NB + b) * 2 + (t - (TT - 2))) * DFF + ch) = acc[m][n];
                    }
                } else if (isS) {
                    const int tt = fr, bs = m;
                    const float* sp = sconv + (size_t)(l * SB + bs) * 2 * DFF + ch;
                    const f32x4 b0 = *(const f32x4*)sp, b1 = *(const f32x4*)(sp + DFF);
                    if (tt == 0) { p1 = b1; p2 = b0; } else if (tt == 1) { p2 = b1; }
                    const long g = NTP + lr;
                    f32x4 gv;
#pragma unroll
                    for (int j = 0; j < 4; ++j) { const float c = bb[j] + w0[j] * p2[j] + w1[j] * p1[j] + w2[j] * acc[m][n][j]; gv[j] = siluf_(c) * acc[m][n + 2][j]; }
                    u32x2 w; w.x = pk2(gv[0], gv[1]); w.y = pk2(gv[2], gv[3]);
                    *(u32x2*)(G + g * DFF + ch) = w;
                    if (tt >= ST_ - 2) *(f32x4*)(out + O_SCONV + ((size_t)(l * SB + bs) * 2 + (tt - (ST_ - 2))) * DFF + ch) = acc[m][n];
                }
                asm volatile("" ::: "memory");
            }
        }
    }
};

DI void prep_weights(int tid0, int bid, const Params& p) {
    const long gt = (long)bid * 512 + tid0, gs = (long)gridDim.x * 512;
    bf16_t* WinT = (bf16_t*)(p.ws + WS_WIN); bf16_t* WqT = (bf16_t*)(p.ws + WS_WQ); bf16_t* WoT = (bf16_t*)(p.ws + WS_WO);
    bf16_t* WupT = (bf16_t*)(p.ws + WS_WUP); bf16_t* WdT = (bf16_t*)(p.ws + WS_WD);
    for (long i = gt; i < 2L * 128 * ZW; i += gs) {
        const int n = (int)(i % ZW), k8 = (int)((i / ZW) % 128), l = (int)(i / (ZW * 128));
        int src = -1;
        if (n < 384) src = n; else if (n < 2432) src = n + 32; else if (n < 2464) src = n - 2432 + 384;
        float v[8];
#pragma unroll
        for (int e = 0; e < 8; ++e) v[e] = src >= 0 ? p.w_in[((size_t)l * 1024 + k8 * 8 + e) * INW + src] : 0.f;
        u32x4 w = {pk2(v[0], v[1]), pk2(v[2], v[3]), pk2(v[4], v[5]), pk2(v[6], v[7])};
        *(u32x4*)(WinT + ((size_t)l * ZW + n) * 1024 + k8 * 8) = w;
    }
    for (long i = gt; i < 2L * 128 * 5632; i += gs) {
        const int n = (int)(i % 5632), k8 = (int)((i / 5632) % 128), l = (int)(i / (5632 * 128));
        const int pn = n >> 8, c = n & 255, wc = c >> 6, nn = (c >> 4) & 3, ii = c & 15;
        const int ch = pn * 128 + wc * 32 + (nn & 1) * 16 + ii;
        const int src = nn < 2 ? ch : DFF + ch;
        float v[8];
#pragma unroll
        for (int e = 0; e < 8; ++e) v[e] = p.w_up[((size_t)l * 1024 + k8 * 8 + e) * (2 * DFF) + src];
        u32x4 w = {pk2(v[0], v[1]), pk2(v[2], v[3]), pk2(v[4], v[5]), pk2(v[6], v[7])};
        *(u32x4*)(WupT + ((size_t)l * 5632 + n) * 1024 + k8 * 8) = w;
    }
    for (long i = gt; i < 2L * 352 * 1024; i += gs) {
        const int n = (int)(i % 1024), k8 = (int)((i / 1024) % 352), l = (int)(i / (1024 * 352));
        float v[8];
#pragma unroll
        for (int e = 0; e < 8; ++e) v[e] = p.w_down[((size_t)l * DFF + k8 * 8 + e) * 1024 + n];
        u32x4 w = {pk2(v[0], v[1]), pk2(v[2], v[3]), pk2(v[4], v[5]), pk2(v[6], v[7])};
        *(u32x4*)(WdT + ((size_t)l * 1024 + n) * DFF + k8 * 8) = w;
    }
    for (long i = gt; i < 2L * 192 * 1024; i += gs) {
        const int n = (int)(i % 1024), k8 = (int)((i / 1024) % 192), l = (int)(i / (1024 * 192));
        float v[8];
        if (k8 < 128) {
            const int h = k8 >> 4, r0 = (k8 & 15) * 8;
#pragma unroll
            for (int e = 0; e < 8; ++e) v[e] = 0.f;
            for (int d = 0; d < 64; ++d) {
                const float wo = p.w_out[((size_t)l * 1024 + h * 64 + d) * 1024 + n];
#pragma unroll
                for (int e = 0; e < 8; ++e) v[e] += p.w_uv[(((size_t)l * 128 + r0 + e) * 8 + h) * 64 + d] * wo;
            }
        } else {
#pragma unroll
            for (int e = 0; e < 8; ++e) v[e] = p.w_out[((size_t)l * 1024 + 512 + (k8 - 128) * 8 + e) * 1024 + n];
        }
        u32x4 w = {pk2(v[0], v[1]), pk2(v[2], v[3]), pk2(v[4], v[5]), pk2(v[6], v[7])};
        *(u32x4*)(WoT + ((size_t)l * 1024 + n) * 1536 + k8 * 8) = w;
    }
    const float qscale = 0.10206207261596577f * 1.4426950408889634f;
    for (long i = gt; i < 2L * 32 * 1280; i += gs) {
        const int n = (int)(i % 1280), k8 = (int)((i / 1280) % 32), l = (int)(i / (1280 * 32));
        float v[8];
        if (n < 1024) {
            const int h = n >> 7, r = n & 127;
#pragma unroll
            for (int e = 0; e < 8; ++e) v[e] = 0.f;
            for (int d = 0; d < 64; ++d) {
                const float wk = p.w_uk[(((size_t)l * 128 + r) * 8 + h) * 64 + d];
#pragma unroll
                for (int e = 0; e < 8; ++e) v[e] += p.w_uq[((size_t)l * 256 + k8 * 8 + e) * 768 + h * 96 + d] * wk;
            }
        } else {
            const int h = (n - 1024) >> 5, ii = (n - 1024) & 31;
#pragma unroll
            for (int e = 0; e < 8; ++e) v[e] = p.w_uq[((size_t)l * 256 + k8 * 8 + e) * 768 + h * 96 + 64 + ii];
        }
#pragma unroll
        for (int e = 0; e < 8; ++e) v[e] *= qscale * p.q_norm[l * 256 + k8 * 8 + e];
        u32x4 w = {pk2(v[0], v[1]), pk2(v[2], v[3]), pk2(v[4], v[5]), pk2(v[6], v[7])};
        *(u32x4*)(WqT + ((size_t)l * 1280 + n) * 256 + k8 * 8) = w;
    }
    float* rope = (float*)(p.ws + WS_ROPE);
    for (long i = gt; i < 2080L * 16; i += gs) {
        const int idx = (int)(i >> 4), k = (int)(i & 15);
        const int pos = idx < TT ? idx - NMETA : PAST + idx - TT;
        const float invf = __builtin_amdgcn_exp2f(-(float)k * (13.287712379549449f / 16.0f));
        const double x = (double)pos * (double)invf * 0.15915494309189535;
        const float fr = (float)(x - __builtin_rint(x));
        rope[i * 2] = __builtin_amdgcn_cosf(fr); rope[i * 2 + 1] = __builtin_amdgcn_sinf(fr);
    }
    float* lb = (float*)(p.ws + WS_LB);
    for (long i = gt; i < 512; i += gs) {
        const float a0 = p.hg_lb[i], a1 = p.hg_lb[512 + i];
        const float mx = fmaxf(a0, a1), e0 = __expf(a0 - mx), e1 = __expf(a1 - mx);
        lb[i] = e1 / (e0 + e1);
    }
    bf16_t* H = (bf16_t*)(p.ws + WS_H);
    for (long i = gt; i < 1024; i += gs) H[(size_t)ZROW * 1024 + i] = 0;
    if (tid0 == 0) {
        unsigned* cnt = (unsigned*)(p.ws + WS_CNT);
        const unsigned xcc = ((unsigned)__builtin_amdgcn_s_getreg((3 << 11) | 20)) & 7u;
        const unsigned slot = atomicAdd(cnt + 16 + xcc, 1u);
        cnt[64 + bid] = (xcc << 16) | slot;
    }
}

DI void rows_phase(int tid0, int bid, const Params& p, int mode, const float* gA, const float* gB, bool first = false) {
    bf16_t* X = (bf16_t*)(p.ws + WS_X);
    bf16_t* H = (bf16_t*)(p.ws + WS_H); const float* RS = (const float*)(p.ws + WS_RS);
    const int lane = tid0 & 63, wv = tid0 >> 6;
    const long stride = (long)gridDim.x * 8;
    constexpr int NR = 4;
    for (long g0 = (long)bid * 8 + wv; g0 < NTOK; g0 += NR * stride) {
        f32x4 x[NR][4]; u32x2 mv[NR][4]; float rsp[NR]; bool ok[NR]; long gr[NR];
#pragma unroll
        for (int u = 0; u < NR; ++u) {
            const long g = g0 + u * stride; gr[u] = g; ok[u] = g < NTOK;
            const long gc = ok[u] ? g : g0;
            const float* src = nullptr;
            if (mode == 0 || first) {
                if (gc < NTP) { const int b = (int)(gc / TT), t = (int)(gc % TT); src = t < NMETA ? p.meta + (size_t)t * 1024 : p.x_prompt + ((size_t)b * 2048 + (t - NMETA)) * 1024; }
                else src = p.x_sample + (size_t)(gc - NTP) * 1024;
            }
            rsp[u] = 0.f;
            if (mode != 0 && lane < 16) rsp[u] = RS[gc * 16 + lane];
#pragma unroll
            for (int i = 0; i < 4; ++i) {
                if (mode == 0 || first) x[u][i] = __builtin_nontemporal_load((const f32x4*)(src + i * 256 + lane * 4));
                else { const u32x2 xv = __builtin_nontemporal_load((const u32x2*)(X + gc * 1024 + i * 256 + lane * 4)); x[u][i] = (f32x4){bflo(xv.x), bfhi(xv.x), bflo(xv.y), bfhi(xv.y)}; }
                mv[u][i] = mode != 0 ? *(const u32x2*)(H + gc * 1024 + i * 256 + lane * 4) : (u32x2){0u, 0u};
            }
        }
#pragma unroll
        for (int u = 0; u < NR; ++u) {
            if (!ok[u]) continue;
            const long g = gr[u];
            if (mode != 0) {
                const float ss = wave_sum(rsp[u]);
                const float r1 = rsqrtf(ss * (1.0f / 1024.0f) + EPS);
#pragma unroll
                for (int i = 0; i < 4; ++i) {
                    const f32x4 ga = *(const f32x4*)(gA + i * 256 + lane * 4);
                    x[u][i][0] += bflo(mv[u][i].x) * r1 * ga[0]; x[u][i][1] += bfhi(mv[u][i].x) * r1 * ga[1];
                    x[u][i][2] += bflo(mv[u][i].y) * r1 * ga[2]; x[u][i][3] += bfhi(mv[u][i].y) * r1 * ga[3];
                }
            }
            float s2 = 0.f;
#pragma unroll
            for (int i = 0; i < 4; ++i) s2 += x[u][i][0] * x[u][i][0] + x[u][i][1] * x[u][i][1] + x[u][i][2] * x[u][i][2] + x[u][i][3] * x[u][i][3];
            s2 = wave_sum(s2);
            const float r2 = rsqrtf(s2 * (1.0f / 1024.0f) + EPS);
            if (mode == 2) {
                float* dst = nullptr;
                if (g < NTP) { const int b = (int)(g / TT), t = (int)(g % TT); if (t >= NMETA) dst = p.out + O_YP + ((size_t)b * 2048 + (t - NMETA)) * 1024; }
                else dst = p.out + O_YS + (size_t)(g - NTP) * 1024;
                if (dst) {
#pragma unroll
                    for (int i = 0; i < 4; ++i) { const f32x4 gb = *(const f32x4*)(gB + i * 256 + lane * 4); __builtin_nontemporal_store(x[u][i] * r2 * gb, (f32x4*)(dst + i * 256 + lane * 4)); }
                }
            } else {
#pragma unroll
                for (int i = 0; i < 4; ++i) {
                    if (mode != 0) { u32x2 xw; xw.x = pk2(x[u][i][0], x[u][i][1]); xw.y = pk2(x[u][i][2], x[u][i][3]); *(u32x2*)(X + g * 1024 + i * 256 + lane * 4) = xw; }
                    const f32x4 gb = *(const f32x4*)(gB + i * 256 + lane * 4);
                    u32x2 w; w.x = pk2(x[u][i][0] * r2 * gb[0], x[u][i][1] * r2 * gb[1]); w.y = pk2(x[u][i][2] * r2 * gb[2], x[u][i][3] * r2 * gb[3]);
                    *(u32x2*)(H + g * 1024 + i * 256 + lane * 4) = w;
                }
            }
        }
    }
}

DI void kv_item(int tid0, LAS char* shm, const Params& p, int l, int type, int b, int tt) {
    const bf16_t* Z = (const bf16_t*)(p.ws + WS_Z);
    const float* rope = (const float*)(p.ws + WS_ROPE);
    int tid = tid0; asm volatile("" : "+v"(tid));
    const int lane = tid & 63, wv = __builtin_amdgcn_readfirstlane(tid >> 6);
    LAS bf16_t* tl = (LAS bf16_t*)shm;
    const int tbase = type == 1 ? PAST : tt * 64;
    const int nvalid = type == 0 ? min(64, TT - tt * 64) : (type == 1 ? ST_ : 64);
    bf16_t* KB; bf16_t* VT; int vld;
    if (type == 0) { KB = (bf16_t*)(p.ws + WS_KBP) + (size_t)b * TT * 160; VT = (bf16_t*)(p.ws + WS_VTP) + (size_t)b * 128 * VTLD_P; vld = VTLD_P; }
    else { KB = (bf16_t*)(p.ws + WS_KBS) + (size_t)b * SKVP * 160; VT = (bf16_t*)(p.ws + WS_VTS) + (size_t)b * 128 * SKVP; vld = SKVP; }
    __syncthreads();
    float in0[8], in1[8], pe0[8], pe1[8];
#pragma unroll
    for (int u = 0; u < 8; ++u) {
        const int tk = wv + 8 * u;
        in0[u] = 0.f; in1[u] = 0.f; pe0[u] = 0.f; pe1[u] = 0.f;
        if (tk < nvalid) {
            const int key = tbase + tk;
            if (type == 2) {
                const f32x2 c = *(const f32x2*)(p.cache_kv + (((size_t)l * SB + b) * PAST + key) * 128 + lane * 2);
                in0[u] = c[0]; in1[u] = c[1];
                if (lane < 16) { const f32x2 pe = *(const f32x2*)(p.cache_pe + (((size_t)l * SB + b) * PAST + key) * 32 + lane * 2); pe0[u] = pe[0]; pe1[u] = pe[1]; }
            } else {
                const long g = type == 0 ? (long)b * TT + key : (long)NTP + b * ST_ + tk;
                const unsigned zz = *(const unsigned*)(Z + g * ZW + ZC_KV + lane * 2);
                in0[u] = bflo(zz); in1[u] = bfhi(zz);
                if (lane < 16) { pe0[u] = bf2f(Z[g * ZW + ZC_PE + lane]); pe1[u] = bf2f(Z[g * ZW + ZC_PE + 16 + lane]); }
            }
        }
    }
#pragma unroll
    for (int u = 0; u < 8; ++u) {
        const int tk = wv + 8 * u;
        float v0 = 0.f, v1 = 0.f;
        if (tk < nvalid) {
            const int key = tbase + tk;
            if (type == 2) {
                v0 = in0[u]; v1 = in1[u];
                if (lane < 16) *(unsigned*)(KB + (size_t)key * 160 + 128 + lane * 2) = pk2(pe0[u], pe1[u]);
            } else {
                const long g = type == 0 ? (long)b * TT + key : (long)NTP + b * ST_ + tk;
                const float a0 = in0[u], a1 = in1[u];
                const float ss = wave_sum(a0 * a0 + a1 * a1);
                const float r = rsqrtf(ss * (1.0f / 128.0f) + EPS);
                const f32x2 gn = *(const f32x2*)(p.kv_norm + l * 128 + lane * 2);
                v0 = a0 * r * gn[0]; v1 = a1 * r * gn[1];
                float* okv = type == 0 ? p.out + O_PKV + (((size_t)l * NB + b) * TT + key) * 128 : p.out + O_SKV + (((size_t)l * SB + b) * ST_ + tk) * 128;
                *(f32x2*)(okv + lane * 2) = (f32x2){v0, v1};
                if (lane < 16) {
                    const float x1 = pe0[u], x2 = pe1[u];
                    const f32x2 cs = *(const f32x2*)(rope + (size_t)pos_index(g) * 32 + lane * 2);
                    const float o1 = x1 * cs[0] - x2 * cs[1], o2 = x1 * cs[1] + x2 * cs[0];
                    float* ope = type == 0 ? p.out + O_PPE + (((size_t)l * NB + b) * TT + key) * 32 : p.out + O_SPE + (((size_t)l * SB + b) * ST_ + tk) * 32;
                    ope[lane] = o1; ope[16 + lane] = o2;
                    KB[(size_t)key * 160 + 128 + lane] = f2bf(o1); KB[(size_t)key * 160 + 144 + lane] = f2bf(o2);
                }
            }
            *(unsigned*)(KB + (size_t)key * 160 + lane * 2) = pk2(v0, v1);
        }
        *(LAS unsigned*)(tl + tk * 130 + lane * 2) = pk2(v0, v1);
    }
    __syncthreads();
    {
        const int dv = tid >> 2, part = tid & 3;
        unsigned w[8];
#pragma unroll
        for (int e = 0; e < 8; ++e) w[e] = (unsigned)tl[(part * 16 + 2 * e) * 130 + dv] | ((unsigned)tl[(part * 16 + 2 * e + 1) * 130 + dv] << 16);
        bf16_t* dst = VT + (size_t)dv * vld + tbase + part * 16;
        *(u32x4*)dst = (u32x4){w[0], w[1], w[4], w[5]};
        *(u32x4*)(dst + 8) = (u32x4){w[2], w[3], w[6], w[7]};
    }
}

#define MFMA32(a, b, c) __builtin_amdgcn_mfma_f32_32x32x16_bf16((a), (b), (c), 0, 0, 0)
constexpr int KSTR = 168, VSTR = 72;
constexpr int ATT_KB = 64 * KSTR * 2, ATT_VB = 128 * VSTR * 2, ATT_BUF = ATT_KB + ATT_VB;
DI void attn_item(int tid0, LAS char* shm, LAS char* shm2, const Params& p, int item) {
    int tid = tid0; asm volatile("" : "+v"(tid));
    const int lane = tid & 63, w = __builtin_amdgcn_readfirstlane(tid >> 6), r = lane & 31, h = lane >> 5;
    bf16_t* QL = (bf16_t*)(p.ws + WS_QL); const bf16_t* QP = (const bf16_t*)(p.ws + WS_QP);
    long rowbase; int nq, kmax, vld; const bf16_t* KB; const bf16_t* VT;
    if (item < SB) {
        const int b = item; rowbase = NTP + b * ST_; nq = ST_; kmax = SKV; vld = SKVP;
        KB = (const bf16_t*)(p.ws + WS_KBS) + (size_t)b * SKVP * 160; VT = (const bf16_t*)(p.ws + WS_VTS) + (size_t)b * 128 * SKVP;
    } else {
        const int a = item - SB, qblk = 64 - a / NB, b = a % NB;
        const int q0 = qblk == 0 ? 0 : 16 + 32 * (qblk - 1);
        nq = qblk == 0 ? 16 : 32; kmax = qblk == 0 ? 16 : 80 + 64 * ((qblk - 1) >> 1); vld = VTLD_P;
        rowbase = (long)b * TT + q0;
        KB = (const bf16_t*)(p.ws + WS_KBP) + (size_t)b * TT * 160; VT = (const bf16_t*)(p.ws + WS_VTP) + (size_t)b * 128 * VTLD_P;
    }
    const int ntiles = (kmax + 63) >> 6;
    const long qrow = rowbase + min(r, nq - 1);
    bf16x8 qf[10];
#pragma unroll
    for (int ks = 0; ks < 8; ++ks) qf[ks] = *(const bf16x8*)(QL + qrow * 1024 + w * 128 + 16 * ks + 8 * h);
#pragma unroll
    for (int ks = 0; ks < 2; ++ks) qf[8 + ks] = *(const bf16x8*)(QP + qrow * 256 + w * 32 + 16 * ks + 8 * h);
    f32x16 O[4];
#pragma unroll
    for (int d = 0; d < 4; ++d)
#pragma unroll
        for (int i = 0; i < 16; ++i) O[d][i] = 0.f;
    float mrun = -INFINITY, lrun = 0.f;
    u32x4 kreg[3], vreg[2];
    const u32x4 zero4 = {0u, 0u, 0u, 0u};
#define ATT_LOAD(t0) do { _Pragma("unroll") for (int i = 0; i < 3; ++i) { const int c = tid + 512 * i; const int key = (t0) + c / 20; \
            kreg[i] = (c < 1280 && key < kmax) ? *(const u32x4*)(KB + (size_t)(t0) * 160 + (size_t)c * 8) : zero4; } \
        _Pragma("unroll") for (int i = 0; i < 2; ++i) { const int c = tid + 512 * i; const int dv = c >> 3, part = c & 7; \
            vreg[i] = ((t0) + part * 8 < kmax) ? *(const u32x4*)(VT + (size_t)dv * vld + (t0) + part * 8) : zero4; } } while (0)
#define ATT_VPTR(j) ((j) == 0 ? (shm + 2 * ATT_KB) : (shm2 + ((j) - 1) * ATT_VB))
#define ATT_STORE(kbuf, vj) do { LAS char* kb_ = shm + (kbuf) * ATT_KB; LAS char* vb_ = ATT_VPTR(vj); \
        _Pragma("unroll") for (int i = 0; i < 3; ++i) { const int c = tid + 512 * i; if (c < 1280) *(LAS u32x4*)(kb_ + ((c / 20) * KSTR + (c % 20) * 8) * 2) = kreg[i]; } \
        _Pragma("unroll") for (int i = 0; i < 2; ++i) { const int c = tid + 512 * i; *(LAS u32x4*)(vb_ + ((c >> 3) * VSTR + (c & 7) * 8) * 2) = vreg[i]; } } while (0)
    const bool grpB = w >= 4;
    bf16x8 pf[2][2];
    float alpha_p = 1.0f;
    auto qk_sm = [&](const LAS bf16_t* Ks, const int t0, const bool last) __attribute__((always_inline)) -> float {
        f32x16 s0, s1;
#pragma unroll
        for (int i = 0; i < 16; ++i) { s0[i] = 0.f; s1[i] = 0.f; }
#pragma unroll
        for (int ks = 0; ks < 10; ++ks) {
            const bf16x8 a0 = *(const LAS bf16x8*)(Ks + r * KSTR + 16 * ks + 8 * h);
            const bf16x8 a1 = *(const LAS bf16x8*)(Ks + (32 + r) * KSTR + 16 * ks + 8 * h);
            s0 = MFMA32(a0, qf[ks], s0); s1 = MFMA32(a1, qf[ks], s1);
        }
        if (last) {
#pragma unroll
            for (int i = 0; i < 16; ++i) {
                const int key = t0 + (i & 3) + 8 * (i >> 2) + 4 * h;
                if (key >= kmax) s0[i] = -INFINITY;
                if (key + 32 >= kmax) s1[i] = -INFINITY;
            }
        }
        float mx = s0[0];
#pragma unroll
        for (int i = 1; i < 16; ++i) mx = fmaxf(mx, s0[i]);
#pragma unroll
        for (int i = 0; i < 16; ++i) mx = fmaxf(mx, s1[i]);
        mx = fmaxf(mx, __shfl_xor(mx, 32));
        const float mnew = fmaxf(mrun, mx);
        const float alpha = __builtin_amdgcn_exp2f(mrun - mnew);
        mrun = mnew;
        float ls = 0.f;
#pragma unroll
        for (int i = 0; i < 16; ++i) { s0[i] = __builtin_amdgcn_exp2f(s0[i] - mnew); s1[i] = __builtin_amdgcn_exp2f(s1[i] - mnew); ls += s0[i] + s1[i]; }
        lrun = lrun * alpha + ls;
#pragma unroll
        for (int s = 0; s < 2; ++s) {
            u32x4 a = {pk2(s0[8 * s], s0[8 * s + 1]), pk2(s0[8 * s + 2], s0[8 * s + 3]), pk2(s0[8 * s + 4], s0[8 * s + 5]), pk2(s0[8 * s + 6], s0[8 * s + 7])};
            u32x4 bq = {pk2(s1[8 * s], s1[8 * s + 1]), pk2(s1[8 * s + 2], s1[8 * s + 3]), pk2(s1[8 * s + 4], s1[8 * s + 5]), pk2(s1[8 * s + 6], s1[8 * s + 7])};
            pf[0][s] = __builtin_bit_cast(bf16x8, a); pf[1][s] = __builtin_bit_cast(bf16x8, bq);
        }
        return alpha;
    };
    auto pv = [&](const LAS bf16_t* Vs, const float alpha) __attribute__((always_inline)) {
        if (__builtin_amdgcn_ballot_w64(alpha != 1.0f) != 0ull) {
#pragma unroll
            for (int d = 0; d < 4; ++d)
#pragma unroll
                for (int i = 0; i < 16; ++i) O[d][i] *= alpha;
        }
#pragma unroll
        for (int d = 0; d < 4; ++d)
#pragma unroll
            for (int kb = 0; kb < 2; ++kb)
#pragma unroll
                for (int s = 0; s < 2; ++s) {
                    const bf16x8 va = *(const LAS bf16x8*)(Vs + (32 * d + r) * VSTR + 32 * kb + 16 * s + 8 * h);
                    O[d] = MFMA32(va, pf[kb][s], O[d]);
                }
    };
    __syncthreads();
    ATT_LOAD(0); ATT_STORE(0, 0); __syncthreads();
    int vj = 0;
    for (int t = 0; t < ntiles; ++t) {
        const int t0 = t * 64;
        if (t + 1 < ntiles) ATT_LOAD(t0 + 64);
        const LAS bf16_t* Ks = (const LAS bf16_t*)(shm + (t & 1) * ATT_KB);
        const int vprev = vj == 0 ? 2 : vj - 1, vnext = vj == 2 ? 0 : vj + 1;
        if (grpB && t > 0) pv((const LAS bf16_t*)ATT_VPTR(vprev), alpha_p);
        alpha_p = qk_sm(Ks, t0, t == ntiles - 1);
        if (!grpB) pv((const LAS bf16_t*)ATT_VPTR(vj), alpha_p);
        if (t + 1 < ntiles) ATT_STORE((t + 1) & 1, vnext);
        __syncthreads();
        vj = vnext;
    }
    if (grpB) { const int vl = vj == 0 ? 2 : vj - 1; pv((const LAS bf16_t*)ATT_VPTR(vl), alpha_p); }
#undef ATT_LOAD
#undef ATT_STORE
#undef ATT_VPTR
    const float ltot = lrun + __shfl_xor(lrun, 32);
    const float inv = 1.0f / ltot;
    if (r < nq) {
        bf16_t* dst = QL + (rowbase + r) * 1024 + w * 128;
#pragma unroll
        for (int d = 0; d < 4; ++d)
#pragma unroll
            for (int g4 = 0; g4 < 4; ++g4) {
                u32x2 wv; wv.x = pk2(O[d][4 * g4] * inv, O[d][4 * g4 + 1] * inv); wv.y = pk2(O[d][4 * g4 + 2] * inv, O[d][4 * g4 + 3] * inv);
                *(u32x2*)(dst + 32 * d + 8 * g4 + 4 * h) = wv;
            }
    }
}

#define MFMA16(a, b, c) __builtin_amdgcn_mfma_f32_16x16x32_bf16((a), (b), (c), 0, 0, 0)
constexpr int SC_QG = 0, SC_KG = 8704, SC_KET = 17408, SC_VT = 27648;
constexpr int SC_ST = 0, SC_AL = 34816, SC_DEC = 37376, SC_PART = 37888, SC_OL = 39936;
DI void scan_item(int tid0, LAS char* shm, LAS char* shm2, const Params& p, int l, int item) {
    int tid = tid0; asm volatile("" : "+v"(tid));
    const int lane = tid & 63, w = __builtin_amdgcn_readfirstlane(tid >> 6), fr = lane & 15, fq = lane >> 4;
    bf16_t* Z = (bf16_t*)(p.ws + WS_Z);
    const bool isS = item >= NB * 4;
    const int b = isS ? (item - NB * 4) >> 2 : item >> 2, hd = item & 3;
    const long row0 = isS ? (long)NTP + b * ST_ : (long)b * TT;
    const int Tn = isS ? ST_ : TT;
    float* Sout = isS ? p.out + O_SS + ((size_t)(l * SB + b) * 4 + hd) * 16384 : p.out + O_PS + ((size_t)(l * NB + b) * 4 + hd) * 16384;
    LAS bf16_t* qG = (LAS bf16_t*)(shm + SC_QG); LAS bf16_t* kg = (LAS bf16_t*)(shm + SC_KG); LAS bf16_t* keT = (LAS bf16_t*)(shm + SC_KET);
    LAS bf16_t* vT = (LAS bf16_t*)(shm + SC_VT); LAS bf16_t* STl = (LAS bf16_t*)(shm2 + SC_ST); LAS bf16_t* Al = (LAS bf16_t*)(shm2 + SC_AL);
    LAS float* dec = (LAS float*)(shm2 + SC_DEC); LAS float* part = (LAS float*)(shm2 + SC_PART); LAS float* ol = (LAS float*)(shm2 + SC_OL);
    const int col = tid & 127, tq = tid >> 7;
    const float lbv = l == 0 ? 0.f : ((const float*)(p.ws + WS_LB))[hd * 128 + col];
    const float oml = 1.0f - lbv;
    f32x4 S[8];
#pragma unroll
    for (int kb = 0; kb < 8; ++kb)
#pragma unroll
        for (int j = 0; j < 4; ++j) S[kb][j] = isS ? p.state_hgrn[(((size_t)(l * SB + b) * 4 + hd) * 128 + 16 * kb + 4 * fq + j) * 128 + 16 * w + fr] : 0.f;
    __syncthreads();
#pragma unroll
    for (int kb = 0; kb < 8; ++kb) { u32x2 wv; wv.x = pk2(S[kb][0], S[kb][1]); wv.y = pk2(S[kb][2], S[kb][3]); *(LAS u32x2*)(STl + (16 * w + fr) * 136 + 16 * kb + 4 * fq) = wv; }
    const int nch = (Tn + 31) >> 5;
    bf16_t rq0[8], rf0[8], rv0[8], rq1[8], rf1[8], rv1[8]; u32x4 hg0, hg1;
#define SC_FETCH(t0, RQ, RF, RV) do { _Pragma("unroll") for (int i = 0; i < 8; ++i) { const int t = (t0) + 8 * tq + i; const bool ok = t < Tn; const bf16_t* zr = Z + (row0 + (ok ? t : 0)) * ZW + hd * 128 + col; \
        RQ[i] = ok ? zr[ZC_HQ] : (bf16_t)0; RF[i] = ok ? zr[ZC_HF] : (bf16_t)0; RV[i] = ok ? zr[ZC_HI] : (bf16_t)0; } } while (0)
#define SC_HG(t0) (((t0) + otok < Tn) ? *(const u32x4*)(Z + (row0 + (t0) + otok) * ZW + ZC_HG + hd * 128 + opart * 8) : (u32x4){0u, 0u, 0u, 0u})
    const int otok = tid >> 4, opart = tid & 15;
    const f32x4 gn0 = *(const f32x4*)(p.hg_on + l * 128 + opart * 8), gn1 = *(const f32x4*)(p.hg_on + l * 128 + opart * 8 + 4);
    SC_FETCH(0, rq0, rf0, rv0); hg0 = SC_HG(0);
    SC_FETCH(32, rq1, rf1, rv1); hg1 = SC_HG(32);
    auto step = [&](const int c, bf16_t (&rq)[8], bf16_t (&rf)[8], bf16_t (&rv)[8], u32x4& hgv) __attribute__((always_inline)) {
        const int t0 = c * 32;
        float cum[8], qq[8], kk[8];
        float run = 0.f;
#pragma unroll
        for (int i = 0; i < 8; ++i) {
            const bool ok = t0 + 8 * tq + i < Tn;
            const float zq = bf2f(rq[i]), zf = bf2f(rf[i]);
            const float sg = sigmoidf_(zf);
            const float f = lbv + oml * sg;
            run += ok ? __logf(f) : 0.f;
            cum[i] = run;
            kk[i] = ok ? oml * (1.0f - sg) : 0.f;
            qq[i] = ok ? siluf_(zq) : 0.f;
        }
        part[tq * 128 + col] = run;
        __syncthreads();
        float pre = 0.f, tot = 0.f;
#pragma unroll
        for (int q = 0; q < 4; ++q) { const float pv = part[q * 128 + col]; tot += pv; if (q < tq) pre += pv; }
        float ke[8];
#pragma unroll
        for (int i = 0; i < 8; ++i) {
            const int tk = 8 * tq + i;
            const float Gi = pre + cum[i];
            qG[tk * 136 + col] = f2bf(qq[i] * __expf(Gi));
            kg[tk * 136 + col] = f2bf(kk[i] * __expf(-fmaxf(Gi, -80.f)));
            ke[i] = kk[i] * __expf(tot - Gi);
        }
        *(LAS u32x4*)(keT + col * 40 + 8 * tq) = (u32x4){pk2(ke[0], ke[1]), pk2(ke[2], ke[3]), pk2(ke[4], ke[5]), pk2(ke[6], ke[7])};
        *(LAS u32x4*)(vT + col * 40 + 8 * tq) = (u32x4){(unsigned)rv[0] | ((unsigned)rv[1] << 16), (unsigned)rv[2] | ((unsigned)rv[3] << 16),
                                                       (unsigned)rv[4] | ((unsigned)rv[5] << 16), (unsigned)rv[6] | ((unsigned)rv[7] << 16)};
        if (tq == 0) dec[col] = __expf(tot);
        __syncthreads();
        if (c + 2 < nch) SC_FETCH(t0 + 64, rq, rf, rv);
        const bool ook = t0 + otok < Tn;
        if (w < 4) {
            const int tb = w >> 1, sb = w & 1;
            f32x4 a = {0.f, 0.f, 0.f, 0.f};
            if (!(tb == 0 && sb == 1)) {
#pragma unroll
                for (int ks = 0; ks < 4; ++ks) {
                    const bf16x8 aq = *(const LAS bf16x8*)(qG + (16 * tb + fr) * 136 + 32 * ks + 8 * fq);
                    const bf16x8 bk = *(const LAS bf16x8*)(kg + (16 * sb + fr) * 136 + 32 * ks + 8 * fq);
                    a = MFMA16(aq, bk, a);
                }
            }
#pragma unroll
            for (int j = 0; j < 4; ++j) { const int t = 16 * tb + 4 * fq + j, s = 16 * sb + fr; Al[t * 40 + s] = f2bf(t >= s ? a[j] : 0.f); }
        }
        f32x4 oa[2] = {{0.f, 0.f, 0.f, 0.f}, {0.f, 0.f, 0.f, 0.f}};
#pragma unroll
        for (int ks = 0; ks < 4; ++ks) {
            const bf16x8 bs = *(const LAS bf16x8*)(STl + (16 * w + fr) * 136 + 32 * ks + 8 * fq);
#pragma unroll
            for (int tb = 0; tb < 2; ++tb) {
                const bf16x8 aq = *(const LAS bf16x8*)(qG + (16 * tb + fr) * 136 + 32 * ks + 8 * fq);
                oa[tb] = MFMA16(aq, bs, oa[tb]);
            }
        }
        __syncthreads();
        const bf16x8 bv = *(const LAS bf16x8*)(vT + (16 * w + fr) * 40 + 8 * fq);
#pragma unroll
        for (int tb = 0; tb < 2; ++tb) {
            const bf16x8 aa = *(const LAS bf16x8*)(Al + (16 * tb + fr) * 40 + 8 * fq);
            oa[tb] = MFMA16(aa, bv, oa[tb]);
        }
#pragma unroll
        for (int kb = 0; kb < 8; ++kb) {
            const f32x4 dv = *(const LAS f32x4*)(dec + 16 * kb + 4 * fq);
            const bf16x8 ak = *(const LAS bf16x8*)(keT + (16 * kb + fr) * 40 + 8 * fq);
            S[kb] = S[kb] * dv;
            S[kb] = MFMA16(ak, bv, S[kb]);
            u32x2 wv; wv.x = pk2(S[kb][0], S[kb][1]); wv.y = pk2(S[kb][2], S[kb][3]);
            *(LAS u32x2*)(STl + (16 * w + fr) * 136 + 16 * kb + 4 * fq) = wv;
        }
#pragma unroll
        for (int tb = 0; tb < 2; ++tb)
#pragma unroll
            for (int j = 0; j < 4; ++j) ol[(16 * tb + 4 * fq + j) * 132 + 16 * w + fr] = oa[tb][j];
        __syncthreads();
        {
            const f32x4 o0 = *(const LAS f32x4*)(ol + otok * 132 + opart * 8), o1 = *(const LAS f32x4*)(ol + otok * 132 + opart * 8 + 4);
            float ss = o0[0] * o0[0] + o0[1] * o0[1] + o0[2] * o0[2] + o0[3] * o0[3] + o1[0] * o1[0] + o1[1] * o1[1] + o1[2] * o1[2] + o1[3] * o1[3];
            ss += __shfl_xor(ss, 1); ss += __shfl_xor(ss, 2); ss += __shfl_xor(ss, 4); ss += __shfl_xor(ss, 8);
            const float rr = rsqrtf(ss * (1.0f / 128.0f) + EPS);
            if (ook) {
                u32x4 wv;
                wv.x = pk2(o0[0] * rr * gn0[0] * siluf_(bflo(hgv.x)), o0[1] * rr * gn0[1] * siluf_(bfhi(hgv.x)));
                wv.y = pk2(o0[2] * rr * gn0[2] * siluf_(bflo(hgv.y)), o0[3] * rr * gn0[3] * siluf_(bfhi(hgv.y)));
                wv.z = pk2(o1[0] * rr * gn1[0] * siluf_(bflo(hgv.z)), o1[1] * rr * gn1[1] * siluf_(bfhi(hgv.z)));
                wv.w = pk2(o1[2] * rr * gn1[2] * siluf_(bflo(hgv.w)), o1[3] * rr * gn1[3] * siluf_(bfhi(hgv.w)));
                *(u32x4*)(Z + (row0 + t0 + otok) * ZW + ZC_HI + hd * 128 + opart * 8) = wv;
            }
        }
        if (c + 2 < nch) hgv = SC_HG(t0 + 64);
    };
    for (int c = 0; c < nch; c += 2) {
        step(c, rq0, rf0, rv0, hg0);
        if (c + 1 < nch) step(c + 1, rq1, rf1, rv1, hg1);
    }
#undef SC_HG
#undef SC_FETCH
#pragma unroll
    for (int kb = 0; kb < 8; ++kb)
#pragma unroll
        for (int j = 0; j < 4; ++j) Sout[(size_t)(16 * kb + 4 * fq + j) * 128 + 16 * w + fr] = S[kb][j];
}

constexpr int N_PH = 1 + 2 * 8;

template <int ph>
DI void run_phase(const Params& pp, LAS char* shm, LAS char* shm2, int* s_item_p) {
#define s_item (*s_item_p)
        Params p = pp;
        asm volatile("" : "+s"(p.ws), "+s"(p.out));
        int tid = threadIdx.x; asm volatile("" : "+v"(tid));
        int bid = blockIdx.x; asm volatile("" : "+s"(bid));
        bf16_t* H = (bf16_t*)(p.ws + WS_H); bf16_t* Z = (bf16_t*)(p.ws + WS_Z); bf16_t* QL = (bf16_t*)(p.ws + WS_QL); bf16_t* QP = (bf16_t*)(p.ws + WS_QP);
        bf16_t* G = (bf16_t*)(p.ws + WS_G); float* RS = (float*)(p.ws + WS_RS);
        if (ph == 0) {
          if (PHMASK & 1) {
            prep_weights(tid, bid, p);
            rows_phase(tid, bid, p, 0, nullptr, p.n_mix_pre);
          }
        } else {
            const int l = (ph - 1) >> 3, sp = (ph - 1) & 7;
            if (sp == 0 && (PHMASK & 2)) {
                const bf16_t* W = (const bf16_t*)(p.ws + WS_WIN) + (size_t)l * ZW * 1024;
                const GemmA ga{H, 1024, nullptr, 0, 1 << 30};
                auto rm = [](int pm, int R) { return pm * 256 + R; };
                const EpiZ epi{Z, RS};
                gemm_phase<false>(tid, bid, (const unsigned*)(p.ws + WS_CNT), shm, shm2, ga, rm, W, 1024, 259, 10, epi);
            } else if (sp == 1 && (PHMASK & 4)) {
                const int nkv = NB * 33 + SB + SB * 64;
                for (int it = bid; it < nkv; it += gridDim.x) {
                    if (it < NB * 33) kv_item(tid, shm, p, l, 0, it / 33, it % 33);
                    else if (it < NB * 33 + SB) kv_item(tid, shm, p, l, 1, it - NB * 33, 0);
                    else { const int a = it - NB * 33 - SB; kv_item(tid, shm, p, l, 2, a >> 6, a & 63); }
                }
                const GemmA ga{Z, ZW, nullptr, 0, 1 << 30};
                auto rm = [](int pm, int R) { return pm * 256 + R; };
                const EpiQ epi{QL, QP, (const float*)(p.ws + WS_ROPE), RS};
                gemm_phase<false>(tid, bid, (const unsigned*)(p.ws + WS_CNT), shm, shm2, ga, rm, (const bf16_t*)(p.ws + WS_WQ) + (size_t)l * 1280 * 256, 256, 259, 5, epi);
            } else if (sp == 2 && (PHMASK & 8)) {
                for (int it = bid; it < NB * 4 + SB * 4; it += gridDim.x) scan_item(tid, shm, shm2, p, l, it);
                unsigned* cnt = (unsigned*)(p.ws + WS_CNT) + l;
                __syncthreads();
                if (tid == 0) s_item = (int)atomicAdd(cnt, 1u);
                for (;;) {
                    __syncthreads();
                    const int it = s_item;
                    if (it >= SB + NB * 65) break;
                    __syncthreads();
                    if (tid == 0) s_item = (int)atomicAdd(cnt, 1u);
                    attn_item(tid, shm, shm2, p, it);
                }
            } else if (sp == 3 && (PHMASK & 16)) {
                const bf16_t* W = (const bf16_t*)(p.ws + WS_WO) + (size_t)l * 1024 * 1536;
                const GemmA ga{QL, 1024, Z + ZC_HI, ZW, 1024};
                auto rm = [](int pm, int R) { return pm * 256 + R; };
                const EpiOut epi{H, RS};
                gemm_phase<true>(tid, bid, (const unsigned*)(p.ws + WS_CNT), shm, shm2, ga, rm, W, 1536, 259, 4, epi);
            } else if (sp == 4 && (PHMASK & 32)) {
                rows_phase(tid, bid, p, 1, p.n_mix_post + l * 1024, p.n_ffn_pre + l * 1024, l == 0);
            } else if (sp == 5 && (PHMASK & 64)) {
                const bf16_t* W = (const bf16_t*)(p.ws + WS_WUP) + (size_t)l * 5632 * 1024;
                const GemmA ga{H, 1024, nullptr, 0, 1 << 30};
                auto rm = [](int pm, int R) -> int {
                    const int st = 2 * pm + (R >> 7), lr = R & 127;
                    if (st < NSUBP) { const int gg = 126 * st - 2 + lr; return (gg >= 0 && gg < NTP) ? gg : ZROW; }
                    if (st == NSUBP) return NTP + lr;
                    return ZROW;
                };
                const EpiUp epi{G, p.conv_w, p.conv_b, p.state_conv, p.out, l};
                gemm_phase<false>(tid, bid, (const unsigned*)(p.ws + WS_CNT), shm, shm2, ga, rm, W, 1024, NMUP, 22, epi);
            } else if (sp == 6 && (PHMASK & 128)) {
                const bf16_t* W = (const bf16_t*)(p.ws + WS_WD) + (size_t)l * 1024 * DFF;
                const GemmA ga{G, DFF, nullptr, 0, 1 << 30};
                auto rm = [](int pm, int R) { return pm * 256 + R; };
                const EpiOut epi{H, RS};
                gemm_phase<false>(tid, bid, (const unsigned*)(p.ws + WS_CNT), shm, shm2, ga, rm, W, DFF, 259, 4, epi);
            } else if (PHMASK & 256) {
                if (l == 0) rows_phase(tid, bid, p, 1, p.n_ffn_post, p.n_mix_pre + 1024);
                else rows_phase(tid, bid, p, 2, p.n_ffn_post + 1024, p.final_norm);
            }
        }
#undef s_item
}

DI void grid_barrier(unsigned* cnt, unsigned k, int bid) {
    asm volatile("s_waitcnt vmcnt(0)" ::: "memory");
    __syncthreads();
    if (threadIdx.x == 0) {
        const unsigned xcc = cnt[64 + bid] >> 16;
        unsigned cx = 0, nx = 0;
#pragma unroll
        for (unsigned x = 0; x < 8; ++x) { const unsigned c = __hip_atomic_load(cnt + 16 + x, __ATOMIC_RELAXED, __HIP_MEMORY_SCOPE_AGENT); nx += c != 0u; cx = x == xcc ? c : cx; }
        const unsigned old = __hip_atomic_fetch_add(cnt + 24 + xcc, 1u, __ATOMIC_RELAXED, __HIP_MEMORY_SCOPE_AGENT);
        if (old + 1u == k * cx) {
            __builtin_amdgcn_fence(__ATOMIC_RELEASE, "agent");
            asm volatile("s_waitcnt vmcnt(0)" ::: "memory");
            __hip_atomic_fetch_add(cnt + 48, 1u, __ATOMIC_RELAXED, __HIP_MEMORY_SCOPE_AGENT);
        }
        while (__hip_atomic_load(cnt + 48, __ATOMIC_RELAXED, __HIP_MEMORY_SCOPE_AGENT) < k * nx) __builtin_amdgcn_s_sleep(20);
        __builtin_amdgcn_fence(__ATOMIC_ACQUIRE, "agent");
        asm volatile("s_waitcnt vmcnt(0)" ::: "memory");
    }
    __syncthreads();
}

template <int ph>
DI void phase_step(const Params& pp, LAS char* shm, LAS char* shm2, int* s_item_p) {
    if (ph >= pp.ph_lo && ph < pp.ph_hi) {
        run_phase<ph>(pp, shm, shm2, s_item_p);
        if ((REPMASK >> ph) & 1) { cg::this_grid().sync(); run_phase<ph>(pp, shm, shm2, s_item_p); }
        if (ph + 1 < pp.ph_hi) {
            if (ph == 0) cg::this_grid().sync();
            else grid_barrier((unsigned*)(pp.ws + WS_CNT), (unsigned)ph, (int)blockIdx.x);
        }
    }
}

__global__ void __launch_bounds__(512, 2) fwd_kernel(Params pp) {
    __shared__ __attribute__((aligned(1024))) char shm_raw[STAGE_B];
    __shared__ __attribute__((aligned(1024))) char shm_raw2[STAGE_B];
    __shared__ int s_item_v;
    LAS char* shm = (LAS char*)shm_raw; LAS char* shm2 = (LAS char*)shm_raw2;
    phase_step<0>(pp, shm, shm2, &s_item_v); phase_step<1>(pp, shm, shm2, &s_item_v); phase_step<2>(pp, shm, shm2, &s_item_v); phase_step<3>(pp, shm, shm2, &s_item_v);
    phase_step<4>(pp, shm, shm2, &s_item_v); phase_step<5>(pp, shm, shm2, &s_item_v); phase_step<6>(pp, shm, shm2, &s_item_v); phase_step<7>(pp, shm, shm2, &s_item_v);
    phase_step<8>(pp, shm, shm2, &s_item_v); phase_step<9>(pp, shm, shm2, &s_item_v); phase_step<10>(pp, shm, shm2, &s_item_v); phase_step<11>(pp, shm, shm2, &s_item_v);
    phase_step<12>(pp, shm, shm2, &s_item_v); phase_step<13>(pp, shm, shm2, &s_item_v); phase_step<14>(pp, shm, shm2, &s_item_v); phase_step<15>(pp, shm, shm2, &s_item_v);
    phase_step<16>(pp, shm, shm2, &s_item_v);
}

extern "C" void kernel_launch(void* const* d_in, const int* in_sizes, int n_in, void* d_out, int out_size, void* d_ws, size_t ws_size, hipStream_t stream) {
    static int grid = 0;
    if (grid == 0) {
        if (ws_size < WS_END) { fprintf(stderr, "kernel_launch: workspace too small: %zu < %zu\n", ws_size, (size_t)WS_END); grid = -1; return; }
        int dev = 0, cus = 0, per_cu = 0;
        hipGetDevice(&dev);
        hipDeviceGetAttribute(&cus, hipDeviceAttributeMultiprocessorCount, dev);
        hipOccupancyMaxActiveBlocksPerMultiprocessor(&per_cu, fwd_kernel, 512, 0);
        if (per_cu < 1) { fprintf(stderr, "kernel_launch: occupancy query says %d blocks/CU\n", per_cu); per_cu = 1; }
        grid = cus * 1;
    }
    if (grid < 0) return;
    if (hipMemsetAsync((char*)d_ws + WS_CNT, 0, 256, stream) != hipSuccess) { fprintf(stderr, "memset failed\n"); return; }
    Params p{};
    const float** f = (const float**)&p;
    for (int i = 0; i < 25; ++i) f[i] = (const float*)d_in[i];
    p.out = (float*)d_out; p.ws = (char*)d_ws;
#if MULTI
    for (int ph = 0; ph < N_PH; ++ph) {
        p.ph_lo = ph; p.ph_hi = ph + 1;
        hipLaunchKernelGGL(fwd_kernel, dim3(grid), dim3(512), 0, stream, p);
    }
#else
    p.ph_lo = 0; p.ph_hi = N_PH;
    void* args[] = {&p};
    hipError_t e = hipLaunchCooperativeKernel((void*)fwd_kernel, dim3(grid), dim3(512), args, 0, stream);
    if (e != hipSuccess) fprintf(stderr, "cooperative launch failed: %s (grid %d)\n", hipGetErrorString(e), grid);
#endif
}
```
